# Optimizing an MI355X kernel written in HIP

```python
import jax, jax.numpy as jnp
from jax import lax
import numpy as np

D_MODEL = 1024
BATCH = 8
SEQ = 2048
DEPTH = 4

HEAD_DIM = D_MODEL // 16
CONV_HEADS = 6
POOL_GROUPS = 4
SGU_HEADS = 6
CONV_W = CONV_HEADS * HEAD_DIM
POOL_W = POOL_GROUPS * HEAD_DIM
SGU_W = SGU_HEADS * HEAD_DIM
D_MIX = CONV_W + POOL_W + SGU_W
D_IN = 3 * CONV_W + POOL_W + 2 * SGU_W
CONV_K = 3
POOL_WINDOWS = (2, 4, 8, 16)
CHUNK = 128
N_EXPERTS = 32
N_GROUPS = 4
EXPERTS_PER_GROUP = N_EXPERTS // N_GROUPS
TOP_K = 2
D_FF = D_MODEL // 2
ROW_BLOCK = 128
ADA_CHUNKS = 6
DEEPNORM_ALPHA = (2 * DEPTH) ** 0.25
DEEPNORM_BETA = (8 * DEPTH) ** -0.25
LN_EPS = 1e-5

kernel_name = "hybrid_conv_pool_sgu_grouped_moe_deepnorm"


def layer_norm(x, g, b):
    xf = x.astype(jnp.float32)
    mu = xf.mean(-1, keepdims=True)
    var = jnp.square(xf - mu).mean(-1, keepdims=True)
    return ((xf - mu) * lax.rsqrt(var + LN_EPS) * g + b).astype(x.dtype)


def short_conv(z, w, b):
    s = z.shape[1]
    zp = jnp.pad(z, ((0, 0), (CONV_K - 1, 0), (0, 0)))
    return w[0] * zp[:, 0:s] + w[1] * zp[:, 1:s + 1] + w[2] * zp[:, 2:s + 2] + b


def pool_mixer(p, w, scale):
    bsz, s, _ = p.shape
    cs = jnp.cumsum(p.astype(jnp.float32), axis=1)
    cs = jnp.pad(cs, ((0, 0), (1, 0), (0, 0)))
    t = jnp.arange(s)
    outs = []
    for gi, win in enumerate(POOL_WINDOWS):
        cg = cs[..., gi * HEAD_DIM:(gi + 1) * HEAD_DIM]
        upper = cg[:, 1:]
        lower = jnp.pad(cg[:, :s - win + 1], ((0, 0), (win - 1, 0), (0, 0)))
        count = jnp.minimum(t + 1, win).astype(jnp.float32)[None, :, None]
        outs.append((upper - lower) / count)
    pooled = jnp.concatenate(outs, axis=-1).astype(p.dtype) - p
    mixed = jnp.einsum('bsgc,gcd->bsgd', pooled.reshape(bsz, s, POOL_GROUPS, HEAD_DIM), w)
    return mixed.reshape(bsz, s, POOL_W) * scale


def spatial_gating(u, v, ln_g, ln_b, w_s, b_s):
    bsz, s, _ = v.shape
    v = layer_norm(v, ln_g, ln_b)
    vh = v.reshape(bsz, s // CHUNK, CHUNK, SGU_HEADS, HEAD_DIM)
    mask = jnp.tril(jnp.ones((CHUNK, CHUNK), dtype=bool))
    ws = jnp.where(mask[None], w_s, jnp.zeros_like(w_s))
    mixed = jnp.einsum('hts,bnshd->bnthd', ws, vh) + b_s.T[None, None, :, :, None]
    return u * mixed.reshape(bsz, s, SGU_W)


def token_mixer(h, w_in, conv_w, conv_b, pool_w, pool_scale, sgu_ln_g, sgu_ln_b, sgu_w, sgu_b, w_out):
    z = h @ w_in
    splits = [CONV_W, 2 * CONV_W, 3 * CONV_W, 3 * CONV_W + POOL_W, 3 * CONV_W + POOL_W + SGU_W]
    gb, gc, xc, p, u, v = jnp.split(z, splits, axis=-1)
    y_conv = gb * short_conv(gc * xc, conv_w, conv_b)
    y_pool = pool_mixer(p, pool_w, pool_scale)
    y_sgu = spatial_gating(u, v, sgu_ln_g, sgu_ln_b, sgu_w, sgu_b)
    y = jnp.concatenate([y_conv, y_pool, y_sgu], axis=-1)
    return y @ w_out


def expert_swiglu(args):
    xb, wg, wu, wd = args
    return (jax.nn.silu(xb @ wg) * (xb @ wu)) @ wd


def grouped_moe(h, w_router, b_router, w_gate, w_up, w_down):
    bsz, s, d = h.shape
    hf = h.reshape(-1, d)
    n_tok = hf.shape[0]
    n_assign = n_tok * TOP_K
    logits = (hf @ w_router + b_router).astype(jnp.float32)
    probs = jax.nn.softmax(logits, axis=-1)
    grouped = probs.reshape(n_tok, N_GROUPS, EXPERTS_PER_GROUP)
    group_score = lax.top_k(grouped, TOP_K)[0].sum(-1)
    g_sel = jnp.argmax(group_score, axis=-1)
    in_group = jnp.take_along_axis(grouped, g_sel[:, None, None], axis=1)[:, 0]
    top_p, top_i = lax.top_k(in_group, TOP_K)
    expert_idx = g_sel[:, None] * EXPERTS_PER_GROUP + top_i
    weights = top_p / top_p.sum(-1, keepdims=True)
    flat_e = expert_idx.reshape(-1).astype(jnp.int32)
    order = jnp.argsort(flat_e)
    sorted_e = flat_e[order]
    tok = order // TOP_K
    sizes = jnp.bincount(flat_e, length=N_EXPERTS).astype(jnp.int32)
    padded = ((sizes + ROW_BLOCK - 1) // ROW_BLOCK) * ROW_BLOCK
    pad_end = jnp.cumsum(padded)
    pad_start = pad_end - padded
    start = jnp.cumsum(sizes) - sizes
    rank = jnp.arange(n_assign, dtype=jnp.int32) - start[sorted_e]
    dest = pad_start[sorted_e] + rank
    n_blocks = n_assign // ROW_BLOCK + N_EXPERTS
    buf = jnp.zeros((n_blocks * ROW_BLOCK, d), h.dtype).at[dest].set(hf[tok])
    block_start = jnp.arange(n_blocks, dtype=jnp.int32) * ROW_BLOCK
    block_e = jnp.minimum(jnp.searchsorted(pad_end, block_start, side='right'), N_EXPERTS - 1)
    xb = buf.reshape(n_blocks, ROW_BLOCK, d)
    yb = lax.map(lambda a: expert_swiglu((a[0], w_gate[a[1]], w_up[a[1]], w_down[a[1]])), (xb, block_e))
    ys = yb.reshape(n_blocks * ROW_BLOCK, d)[dest]
    w_sorted = weights.reshape(-1)[order].astype(h.dtype)
    out = jnp.zeros_like(hf).at[tok].add(ys * w_sorted[:, None])
    return out.reshape(bsz, s, d)


def setup_inputs(seed: int = 0) -> dict:
    key = jax.random.key(seed)
    ks = jax.random.split(key, 24)
    f32 = jnp.float32
    nrm = lambda k, shape, sc: jax.random.normal(k, shape, f32) * sc
    L, D = DEPTH, D_MODEL
    return {
        "x": nrm(ks[0], (BATCH, SEQ, D), 1.0),
        "c": nrm(ks[1], (BATCH, D), 1.0),
        "w_ada": nrm(ks[2], (L, D, ADA_CHUNKS * D), 0.5 * D ** -0.5),
        "b_ada": nrm(ks[3], (L, ADA_CHUNKS * D), 0.01),
        "w_in": nrm(ks[4], (L, D, D_IN), D ** -0.5),
        "conv_w": nrm(ks[5], (L, CONV_K, CONV_W), CONV_K ** -0.5),
        "conv_b": nrm(ks[6], (L, CONV_W), 0.01),
        "pool_w": nrm(ks[7], (L, POOL_GROUPS, HEAD_DIM, HEAD_DIM), HEAD_DIM ** -0.5),
        "pool_scale": 1.0 + nrm(ks[8], (L, POOL_W), 0.1),
        "sgu_ln_g": 1.0 + nrm(ks[9], (L, SGU_W), 0.01),
        "sgu_ln_b": nrm(ks[10], (L, SGU_W), 0.01),
        "sgu_w": nrm(ks[11], (L, SGU_HEADS, CHUNK, CHUNK), CHUNK ** -0.5),
        "sgu_b": 1.0 + nrm(ks[12], (L, SGU_HEADS, CHUNK), 0.01),
        "w_out": nrm(ks[13], (L, D_MIX, D), DEEPNORM_BETA * D_MIX ** -0.5),
        "ln1_g": 1.0 + nrm(ks[14], (L, D), 0.01),
        "ln1_b": nrm(ks[15], (L, D), 0.01),
        "w_router": nrm(ks[16], (D, N_EXPERTS), D ** -0.5),
        "b_router": nrm(ks[17], (N_EXPERTS,), 0.01),
        "w_gate": nrm(ks[18], (L, N_EXPERTS, D, D_FF), D ** -0.5),
        "w_up": nrm(ks[19], (L, N_EXPERTS, D, D_FF), D ** -0.5),
        "w_down": nrm(ks[20], (L, N_EXPERTS, D_FF, D), DEEPNORM_BETA * D_FF ** -0.5),
        "ln2_g": 1.0 + nrm(ks[21], (L, D), 0.01),
        "ln2_b": nrm(ks[22], (L, D), 0.01),
    }


def reference(x, c, w_ada, b_ada, w_in, conv_w, conv_b, pool_w, pool_scale, sgu_ln_g, sgu_ln_b,
              sgu_w, sgu_b, w_out, ln1_g, ln1_b, w_router, b_router, w_gate, w_up, w_down,
              ln2_g, ln2_b):
    c_act = jax.nn.silu(c)
    for l in range(DEPTH):
        ada = c_act @ w_ada[l] + b_ada[l]
        sh1, sc1, g1, sh2, sc2, g2 = [a[:, None, :] for a in jnp.split(ada, ADA_CHUNKS, axis=-1)]
        h = x * (1.0 + sc1) + sh1
        y = token_mixer(h, w_in[l], conv_w[l], conv_b[l], pool_w[l], pool_scale[l],
                        sgu_ln_g[l], sgu_ln_b[l], sgu_w[l], sgu_b[l], w_out[l])
        x = layer_norm(DEEPNORM_ALPHA * x + g1 * y, ln1_g[l], ln1_b[l])
        h = x * (1.0 + sc2) + sh2
        y = grouped_moe(h, w_router, b_router, w_gate[l], w_up[l], w_down[l])
        x = layer_norm(DEEPNORM_ALPHA * x + g2 * y, ln2_g[l], ln2_b[l])
    return x
```

```cpp
#include <hip/hip_runtime.h>
#include <cstdio>
#include <cstdint>

#ifndef ONE_LAUNCH
#define ONE_LAUNCH 1
#endif

#define LAS __attribute__((address_space(3)))
typedef unsigned short bf16_t;
typedef short bf16x8 __attribute__((ext_vector_type(8)));
typedef unsigned short u16x4 __attribute__((ext_vector_type(4)));
typedef float f32x4 __attribute__((ext_vector_type(4)));
typedef float f32x2 __attribute__((ext_vector_type(2)));
typedef unsigned u32x4 __attribute__((ext_vector_type(4)));
typedef unsigned u32x2 __attribute__((ext_vector_type(2)));

constexpr int D = 1024, NB = 8, SEQ = 2048, T = NB * SEQ, DEPTH = 4;
constexpr int CONV_W = 384, POOL_W = 256, SGU_W = 384, D_IN = 2176, ZLD = 2304, CHUNK = 128;
constexpr int NE = 32, DFF = 512, LCAP = 16384;
constexpr int OFF_GB = 0, OFF_GC = 384, OFF_XC = 768, OFF_P = 1152, OFF_U = 1408, OFF_V = 1792;
constexpr float ALPHA = 1.681792830507429f, LN_EPS = 1e-5f;
constexpr int NTHR = 512;

constexpr size_t al256(size_t x) { return (x + 255) & ~(size_t)255; }
constexpr size_t WS_CTL = 0;
constexpr size_t CTL_BYTES = 65536;
constexpr size_t CTL_CNT = 16384;
constexpr size_t WS_ADA = WS_CTL + CTL_BYTES;
constexpr size_t WS_WRT = WS_ADA + al256((size_t)DEPTH * NB * 6144 * 4);
constexpr size_t WS_SGUW = WS_WRT + al256((size_t)NE * D * 4);
constexpr size_t WS_POOLW = WS_SGUW + al256((size_t)DEPTH * 6 * 128 * 128 * 2);
constexpr size_t WS_WIN = WS_POOLW + al256((size_t)DEPTH * 4 * 64 * 64 * 2);
constexpr size_t WS_WOUT = WS_WIN + al256((size_t)DEPTH * ZLD * D * 2);
constexpr size_t WS_WGU = WS_WOUT + al256((size_t)DEPTH * D * D * 2);
constexpr size_t WS_WDN = WS_WGU + al256((size_t)DEPTH * NE * 1024 * 1024 * 2);
constexpr size_t WS_X = WS_WDN + al256((size_t)DEPTH * NE * 1024 * 512 * 2);
constexpr size_t WS_H = WS_X + al256((size_t)T * D * 4);
constexpr size_t WS_Z = WS_H + al256((size_t)T * D * 2);
constexpr size_t WS_Y = WS_Z + al256((size_t)T * ZLD * 2);
constexpr size_t WS_ACT = WS_Y + al256((size_t)T * D * 2);
constexpr size_t WS_YMOE = WS_ACT + al256((size_t)(2 * T + NE * 256) * DFF * 2);
constexpr size_t WS_LISTA = WS_YMOE + al256((size_t)2 * T * D * 2);
constexpr size_t WS_LISTW = WS_LISTA + al256((size_t)NE * LCAP * 4);
constexpr size_t WS_SMALL = WS_LISTW + al256((size_t)NE * LCAP * 4);
constexpr size_t WS_END = WS_SMALL + al256((size_t)29728 * 4);
constexpr int SM_CONVW = 0, SM_CONVB = 4608, SM_PSCALE = 6144, SM_LNG = 7168, SM_LNB = 8704, SM_SGUB = 10240, SM_LN1G = 13312, SM_LN1B = 17408, SM_LN2G = 21504, SM_LN2B = 25600, SM_BR = 29696;

constexpr int LDS_BYTES = 147456;
constexpr int TAB_OFF = 131072;
constexpr int SCHED_OFF = TAB_OFF + 6144;
constexpr int MISC_OFF = SCHED_OFF + 2048;

#define XB_TMO      128
#define XB_XCNT(j)  (256  + 64 * (j))
#define XB_XSUB(j)  (1280 + 64 * (j))
#define XB_XGEN(j)  (2304 + 64 * (j))
#define XB_TOP      3328
#define XB_TOPGEN   3392
#define XCD_BAR_WORDS 3456
#define XB_SPIN_CAP (1u << 18)

__device__ __forceinline__ unsigned xb_ld(unsigned* p)              { return __hip_atomic_load(p, __ATOMIC_RELAXED, __HIP_MEMORY_SCOPE_AGENT); }
__device__ __forceinline__ unsigned xb_add(unsigned* p, unsigned v) { return __hip_atomic_fetch_add(p, v, __ATOMIC_RELAXED, __HIP_MEMORY_SCOPE_AGENT); }
__device__ __forceinline__ unsigned xb_xcc_id() { return (unsigned)__builtin_amdgcn_s_getreg((3 << 11) | 20) & 0xFu; }
#define XB_SPIN(cond, bar) do { unsigned _sp = 0; while (cond) { __builtin_amdgcn_s_sleep(1); \
    if ((++_sp & 255u) == 0u) { if (xb_ld(&(bar)[XB_TMO])) break; if (_sp > XB_SPIN_CAP) { atomicAdd(&(bar)[XB_TMO], 1u); break; } } } } while (0)

struct XcdBarrier {
    unsigned* bar; unsigned x;
    volatile LAS unsigned* st;
};

__device__ __forceinline__ XcdBarrier xcd_barrier_post(unsigned* bar, volatile LAS unsigned* st) {
    XcdBarrier b; b.bar = bar; b.x = xb_xcc_id(); b.st = st;
    if (threadIdx.x == 0) (void)xb_add(&bar[XB_XCNT(b.x)], 1u);
    return b;
}
__device__ __forceinline__ void xcd_barrier_complete(unsigned* bar, unsigned x, unsigned& nloc, unsigned& nx) {
    const unsigned G = gridDim.x * gridDim.y * gridDim.z;
    unsigned sum, cnt, mine, sp = 0u;
    for (;;) {
        sum = 0u; cnt = 0u; mine = 0u;
#pragma unroll
        for (unsigned j = 0; j < 16; ++j) { const unsigned c = xb_ld(&bar[XB_XCNT(j)]); sum += c; cnt += (c > 0u) ? 1u : 0u; mine = (j == x) ? c : mine; }
        if (sum == G) break;
        __builtin_amdgcn_s_sleep(1);
        if ((++sp & 255u) == 0u) { if (xb_ld(&bar[XB_TMO])) break; if (sp > XB_SPIN_CAP) { atomicAdd(&bar[XB_TMO], 1u); break; } }
    }
    nloc = mine > 0u ? mine : 1u; nx = cnt > 0u ? cnt : 1u;
}

__device__ __forceinline__ void xcd_barrier(const XcdBarrier& b) {
    asm volatile("s_waitcnt vmcnt(0)" ::: "memory");
    __syncthreads();
    if (threadIdx.x == 0) {
        unsigned* bar = b.bar;
        __builtin_amdgcn_s_waitcnt(0);
        unsigned nloc = b.st[0], nx = b.st[1];
        if (nloc == 0u) { xcd_barrier_complete(bar, b.x, nloc, nx); b.st[0] = nloc; b.st[1] = nx; }
        const unsigned old = xb_add(&bar[XB_XSUB(b.x)], 1u);
        const unsigned gen = old / nloc;
        if (old + 1u == (gen + 1u) * nloc) {
            __builtin_amdgcn_fence(__ATOMIC_RELEASE, "agent");
            asm volatile("s_waitcnt vmcnt(0)" ::: "memory");
            const unsigned og = xb_add(&bar[XB_TOP], 1u);
            const unsigned tg = og / nx;
            if (og + 1u == (tg + 1u) * nx) xb_add(&bar[XB_TOPGEN], 1u);
            else XB_SPIN(xb_ld(&bar[XB_TOPGEN]) == tg, bar);
            __builtin_amdgcn_fence(__ATOMIC_ACQUIRE, "agent");
            xb_add(&bar[XB_XGEN(b.x)], 1u);
            asm volatile("s_waitcnt vmcnt(0)" ::: "memory");
        } else {
            XB_SPIN(xb_ld(&bar[XB_XGEN(b.x)]) == gen, bar);
            __builtin_amdgcn_fence(__ATOMIC_ACQUIRE, "agent");
            asm volatile("s_waitcnt vmcnt(0)" ::: "memory");
        }
    }
    __syncthreads();
}

__device__ __forceinline__ int tid_l() { int t = threadIdx.x; asm volatile("" : "+v"(t)); return t; }
__device__ __forceinline__ unsigned cvt_pk_bf16(float lo, float hi) { unsigned r; asm("v_cvt_pk_bf16_f32 %0, %1, %2" : "=v"(r) : "v"(lo), "v"(hi)); return r; }
__device__ __forceinline__ float bf_lo(unsigned u) { return __uint_as_float(u << 16); }
__device__ __forceinline__ float bf_hi(unsigned u) { return __uint_as_float(u & 0xffff0000u); }
__device__ __forceinline__ void unpack8(const u32x4 v, float (&f)[8]) {
    f[0] = bf_lo(v.x); f[1] = bf_hi(v.x); f[2] = bf_lo(v.y); f[3] = bf_hi(v.y); f[4] = bf_lo(v.z); f[5] = bf_hi(v.z); f[6] = bf_lo(v.w); f[7] = bf_hi(v.w);
}
__device__ __forceinline__ u32x4 pack8(const float (&f)[8]) { u32x4 w; w.x = cvt_pk_bf16(f[0], f[1]); w.y = cvt_pk_bf16(f[2], f[3]); w.z = cvt_pk_bf16(f[4], f[5]); w.w = cvt_pk_bf16(f[6], f[7]); return w; }
__device__ __forceinline__ float silu_f(float g) { return g * __builtin_amdgcn_rcpf(1.0f + __expf(-g)); }
__device__ __forceinline__ float wave_sum(float s) {
#pragma unroll
    for (int o = 32; o; o >>= 1) s += __shfl_xor(s, o);
    return s;
}

constexpr int BM = 256, BK = 64, HALF = 128, HTB = HALF * BK * 2, NXCD = 8, WGM = 8;
__host__ __device__ __forceinline__ int lds_byte(int r, int c) { const int st = (r >> 4) * 2 + (c >> 5), rr = r & 15, cc = c & 31, ob = rr * 64 + cc * 2; return st * 1024 + (ob ^ (((ob >> 9) & 1) << 5)); }
__host__ __device__ __forceinline__ void stage_rc(int b, int& R, int& C) { const int st = b / 1024, sb = b % 1024, swz = sb ^ (((sb >> 9) & 1) << 5); R = (st >> 1) * 16 + swz / 64; C = (st & 1) * 32 + (swz % 64) / 2; }
__host__ __device__ __forceinline__ int perm32(int rho) { const int n = rho >> 4, i = rho & 15; return 8 * (i >> 2) + 4 * n + (i & 3); }

struct Unit { int arow, brow, orow, pn, nvalid, tsrc; };

struct DenseOrder {
    int nM, nN, nwg, G, c;
    __device__ void init(int M, int N, int G_, int c_) { nM = M / BM; nN = N / BM; nwg = nM * nN; G = G_; c = c_; }
    __device__ bool next(int i, Unit& u) const {
        const long L = (long)i * G + c; if (L >= nwg) return false;
        int wgid = (int)L; { const int q = nwg / NXCD, r = nwg % NXCD, xcd = wgid % NXCD, off = wgid / NXCD; wgid = (xcd < r ? xcd * (q + 1) : r * (q + 1) + (xcd - r) * q) + off; }
        const int nig = WGM * nN, gid = wgid / nig, fm = gid * WGM, gsz = (nM - fm) < WGM ? (nM - fm) : WGM;
        const int pm = fm + ((wgid % nig) % gsz), pn = (wgid % nig) / gsz;
        u.arow = pm * BM; u.brow = pn * BM; u.orow = pm * BM; u.pn = pn; u.nvalid = 256; u.tsrc = 0; return true;
    }
};
struct MoeOrder {
    const LAS int* sched; int NT, G, c;
    __device__ bool next(int i, Unit& u) const {
        const int uu = i * G + c, tl = uu >> 2; if (tl >= NT) return false;
        const int pn = uu & 3, e = __builtin_amdgcn_readfirstlane(sched[96 + tl]), r0 = (tl - __builtin_amdgcn_readfirstlane(sched[32 + e])) * 256, rem = __builtin_amdgcn_readfirstlane(sched[e]) - r0;
        u.arow = tl * 256; u.brow = e * 1024 + pn * 256; u.orow = tl * 256; u.pn = pn; u.nvalid = rem < 256 ? rem : 256; u.tsrc = e * LCAP + r0; return true;
    }
};

template <class P>
__device__ __forceinline__ void gemm_phase(LAS unsigned char* lds, const P& S) {
    constexpr int MODE = P::MODE;
    const int tid = tid_l(), wid = __builtin_amdgcn_readfirstlane(tid >> 6), lane = tid & 63, wr = wid >> 2, wc = wid & 3, fr = lane & 15, fq = lane >> 4;
    const int K = S.K, nt = K / BK;
    unsigned voffA[2], voffB[2];
#pragma unroll
    for (int i = 0; i < 2; ++i) { int R, C; stage_rc(tid * 16 + i * 8192, R, C); const int Rb = P::PERM ? ((R & ~31) + perm32(R & 31)) : R;
        voffA[i] = (unsigned)(R * K + C) * 2u; voffB[i] = (unsigned)(Rb * K + C) * 2u; }
    const size_t kstep = (size_t)(BK * 2);
    const size_t hstep = (size_t)HALF * K * 2;
    const unsigned ldsw = (unsigned)wid * 1024u;
    const int aoff = lds_byte(wr * 64 + fr, fq * 8), boff = lds_byte(wc * 32 + fr, fq * 8);
    LAS int* tabA = (LAS int*)(lds + TAB_OFF); LAS float* tabW = (LAS float*)(lds + TAB_OFF + 3072);
#define G_SA(b, h) (((b) * 2 + (h)) * HTB)
#define G_SB(b, h) ((4 + (b) * 2 + (h)) * HTB)
#define G_STAGE(bufoff, gbase, voff) do { _Pragma("unroll") for (int _i = 0; _i < 2; ++_i) \
        __builtin_amdgcn_global_load_lds((const unsigned*)((const char*)(gbase) + (voff)[_i]), (LAS unsigned*)(lds + (bufoff) + ldsw + _i * 8192), 16, 0, 0); } while (0)
#define G_STAGE_A(bufoff, dptr, h, kb) do { if constexpr (MODE == 1) { _Pragma("unroll") for (int _i = 0; _i < 2; ++_i) \
        __builtin_amdgcn_global_load_lds((const unsigned*)(S.A + (size_t)gofs[h][_i] + (kb)), (LAS unsigned*)(lds + (bufoff) + ldsw + _i * 8192), 16, 0, 0); } \
        else { G_STAGE(bufoff, (dptr) + (size_t)(h) * hstep + (kb), voffA); } } while (0)
#define G_GOFS(sl) do { int _tz = threadIdx.x; asm volatile("" : "+v"(_tz)); _Pragma("unroll") for (int _i = 0; _i < 2; ++_i) { int _R, _C; stage_rc(_tz * 16 + _i * 8192, _R, _C); \
        _Pragma("unroll") for (int _h = 0; _h < 2; ++_h) gofs[_h][_i] = (unsigned)(tabA[(sl) * 256 + _h * 128 + _R] >> 1) * (unsigned)(K * 2) + (unsigned)(_C * 2); } } while (0)
#define G_LDA(dst, b, h) do { _Pragma("unroll") for (int m = 0; m < 4; ++m) _Pragma("unroll") for (int k = 0; k < 2; ++k) dst[m][k] = *(const LAS bf16x8*)(lds + G_SA(b, h) + aoff + m * 2048 + k * 1024); } while (0)
#define G_LDB(dst, b, h) do { _Pragma("unroll") for (int n = 0; n < 2; ++n) _Pragma("unroll") for (int k = 0; k < 2; ++k) dst[n][k] = *(const LAS bf16x8*)(lds + G_SB(b, h) + boff + n * 2048 + k * 1024); } while (0)
#define G_MMA(ai, bj, At, Bt) do { __builtin_amdgcn_s_setprio(1); _Pragma("unroll") for (int m = 0; m < 4; ++m) _Pragma("unroll") for (int n = 0; n < 2; ++n) _Pragma("unroll") for (int k = 0; k < 2; ++k) \
        acc[ai][bj][m][n] = __builtin_amdgcn_mfma_f32_16x16x32_bf16(Bt[n][k], At[m][k], acc[ai][bj][m][n], 0, 0, 0); __builtin_amdgcn_s_setprio(0); } while (0)
#define G_WAIT_V(n) asm volatile("s_waitcnt vmcnt(" #n ")" ::: "memory")
#define G_WAIT_L(n) asm volatile("s_waitcnt lgkmcnt(" #n ")" ::: "memory")
#define G_BAR __builtin_amdgcn_s_barrier()
#define G_SCHED __builtin_amdgcn_sched_barrier(0)
    Unit cur, nxt; int ui = 0;
    if (!S.next(0, cur)) return;
    f32x4 acc[2][2][4][2];
#pragma unroll
    for (int a = 0; a < 2; ++a)
#pragma unroll
        for (int b = 0; b < 2; ++b)
#pragma unroll
            for (int m = 0; m < 4; ++m)
#pragma unroll
                for (int n = 0; n < 2; ++n) acc[a][b][m][n] = (f32x4){0.f, 0.f, 0.f, 0.f};
    bf16x8 At[4][2], B0[2][2], B1[2][2];
    unsigned gofs[2][2] = {{0u, 0u}, {0u, 0u}};
    if constexpr (MODE != 0) {
        if (tid < 256) { const int rl = cur.nvalid - 1; const int idx = cur.tsrc + (tid < rl ? tid : rl);
            tabA[tid] = S.lista[idx]; if constexpr (MODE == 1) tabW[tid] = S.listw[idx]; }
        __syncthreads();
        if constexpr (MODE == 1) G_GOFS(0);
    }
    const char* cA = S.A + (size_t)cur.arow * K * 2; const char* cB = S.B + (size_t)cur.brow * K * 2;
    G_STAGE(G_SB(0, 0), cB, voffB); G_STAGE_A(G_SA(0, 0), cA, 0, 0); G_STAGE(G_SB(0, 1), cB + hstep, voffB); G_STAGE_A(G_SA(0, 1), cA, 1, 0);
    if (wr == 1) G_BAR;
    G_WAIT_V(4); G_BAR;
    G_STAGE(G_SB(1, 0), cB + kstep, voffB); G_STAGE_A(G_SA(1, 0), cA, 0, kstep); G_STAGE(G_SB(1, 1), cB + hstep + kstep, voffB);
    G_WAIT_V(6); G_BAR;
    for (;;) {
        const bool has_next = S.next(ui + 1, nxt);
        const char* nA = has_next ? S.A + (size_t)nxt.arow * K * 2 : cA; const char* nB = has_next ? S.B + (size_t)nxt.brow * K * 2 : cB;
        const int slot_n = (ui + 1) % 3;
        if constexpr (MODE != 0) {
            if (has_next && wid < 4) {
                const int rr = tid_l(), rl = nxt.nvalid - 1; const int idx = nxt.tsrc + (rr < rl ? rr : rl);
                __builtin_amdgcn_global_load_lds((const unsigned*)(S.lista + idx), (LAS unsigned*)(tabA + slot_n * 256 + wid * 64), 4, 0, 0);
                if constexpr (MODE == 1) __builtin_amdgcn_global_load_lds((const unsigned*)(S.listw + idx), (LAS unsigned*)(tabW + slot_n * 256 + wid * 64), 4, 0, 0);
            }
        }
        for (int t = 0; t < nt; t += 2) {
            const bool last = (t == nt - 2);
            const size_t k1 = (size_t)(t + 1) * kstep;
            const size_t k2 = last ? 0 : (size_t)(t + 2) * kstep, k3 = k2 + kstep;
            const char* a2p = last ? nA : cA; const char* b2 = (last ? nB : cB) + k2; const char* b3 = b2 + kstep;
            G_LDB(B0, 0, 0); G_SCHED; G_LDA(At, 0, 0); G_STAGE_A(G_SA(1, 1), cA, 1, k1);
            G_WAIT_L(8); G_BAR; G_WAIT_L(0); G_MMA(0, 0, At, B0); G_BAR; G_SCHED;
            if constexpr (MODE == 1) { if (last && has_next) G_GOFS(slot_n); }
            G_LDB(B1, 0, 1); G_STAGE(G_SB(0, 0), b2, voffB);
            G_BAR; G_WAIT_L(0); G_MMA(0, 1, At, B1); G_BAR;
            G_LDA(At, 0, 1); G_STAGE_A(G_SA(0, 0), a2p, 0, k2);
            G_BAR; G_WAIT_L(0); G_MMA(1, 0, At, B0); G_BAR; G_SCHED;
            G_STAGE(G_SB(0, 1), b2 + hstep, voffB);
            G_WAIT_V(6); G_BAR; G_MMA(1, 1, At, B1); G_BAR;
            G_LDB(B0, 1, 0); G_SCHED; G_LDA(At, 1, 0); G_STAGE_A(G_SA(0, 1), a2p, 1, k2);
            G_WAIT_L(8); G_BAR; G_WAIT_L(0); G_MMA(0, 0, At, B0); G_BAR; G_SCHED;
            G_LDB(B1, 1, 1); G_STAGE(G_SB(1, 0), b3, voffB);
            G_BAR; G_WAIT_L(0); G_MMA(0, 1, At, B1); G_BAR;
            G_LDA(At, 1, 1); G_STAGE_A(G_SA(1, 0), a2p, 0, k3);
            G_BAR; G_WAIT_L(0); G_MMA(1, 0, At, B0); G_BAR; G_SCHED;
            G_STAGE(G_SB(1, 1), b3 + hstep, voffB);
            G_WAIT_V(6); G_BAR; G_MMA(1, 1, At, B1); G_BAR;
        }
        S.epi(acc, cur, tabA + (ui % 3) * 256, tabW + (ui % 3) * 256);
        if (!has_next) break;
#pragma unroll
        for (int a = 0; a < 2; ++a)
#pragma unroll
            for (int b = 0; b < 2; ++b)
#pragma unroll
                for (int m = 0; m < 4; ++m)
#pragma unroll
                    for (int n = 0; n < 2; ++n) acc[a][b][m][n] = (f32x4){0.f, 0.f, 0.f, 0.f};
        cur = nxt; cA = nA; cB = nB; ++ui;
    }
    G_WAIT_V(0);
    if (wr == 0) G_BAR;
    G_BAR;
#undef G_SA
#undef G_SB
#undef G_STAGE
#undef G_STAGE_A
#undef G_GOFS
#undef G_LDA
#undef G_LDB
#undef G_MMA
#undef G_WAIT_V
#undef G_WAIT_L
#undef G_BAR
#undef G_SCHED
}

struct PolIn {
    static constexpr int MODE = 0; static constexpr bool PERM = true;
    int K; const char* A; const char* B; const int* lista; const float* listw; DenseOrder ord; bf16_t* Z;
    __device__ bool next(int i, Unit& u) const { return ord.next(i, u); }
    __device__ __forceinline__ void epi(const f32x4 (&acc)[2][2][4][2], const Unit& u, const LAS int*, const LAS float*) const {
        const int tz = tid_l(), wid = tz >> 6, lane = tz & 63, wr = wid >> 2, wc = wid & 3, fr = lane & 15, fq = lane >> 4;
        const int row0 = u.orow + wr * 64 + fr, col0 = u.pn * BM + wc * 32 + 8 * fq;
#pragma unroll
        for (int ai = 0; ai < 2; ++ai)
#pragma unroll
            for (int m = 0; m < 4; ++m) { bf16_t* rowp = Z + (size_t)(row0 + ai * HALF + m * 16) * ZLD + col0;
#pragma unroll
                for (int bj = 0; bj < 2; ++bj) { const f32x4 v0 = acc[ai][bj][m][0], v1 = acc[ai][bj][m][1];
                    u32x4 w; w.x = cvt_pk_bf16(v0[0], v0[1]); w.y = cvt_pk_bf16(v0[2], v0[3]); w.z = cvt_pk_bf16(v1[0], v1[1]); w.w = cvt_pk_bf16(v1[2], v1[3]);
                    *(u32x4*)(rowp + bj * HALF) = w; } }
    }
};
struct PolOut {
    static constexpr int MODE = 0; static constexpr bool PERM = false;
    int K; const char* A; const char* B; const int* lista; const float* listw; DenseOrder ord; const float* xsrc; float* xres; const float* g1;
    __device__ bool next(int i, Unit& u) const { return ord.next(i, u); }
    __device__ __forceinline__ void epi(const f32x4 (&acc)[2][2][4][2], const Unit& u, const LAS int*, const LAS float*) const {
        const int tz = tid_l(), wid = tz >> 6, lane = tz & 63, wr = wid >> 2, wc = wid & 3, fr = lane & 15, fq = lane >> 4;
        const int row0 = u.orow + wr * 64 + fr, col0 = u.pn * BM + wc * 32 + 4 * fq;
        const float* gp = g1 + (size_t)(u.orow / SEQ) * 6144 + col0;
        f32x4 gv[2][2];
#pragma unroll
        for (int bj = 0; bj < 2; ++bj)
#pragma unroll
            for (int n = 0; n < 2; ++n) gv[bj][n] = *(const f32x4*)(gp + bj * HALF + n * 16);
#pragma unroll
        for (int ai = 0; ai < 2; ++ai)
#pragma unroll
            for (int m = 0; m < 4; ++m) { const size_t off = (size_t)(row0 + ai * HALF + m * 16) * D + col0;
#pragma unroll
                for (int bj = 0; bj < 2; ++bj)
#pragma unroll
                    for (int n = 0; n < 2; ++n) { const f32x4 xs = *(const f32x4*)(xsrc + off + bj * HALF + n * 16);
                        *(f32x4*)(xres + off + bj * HALF + n * 16) = xs * ALPHA + gv[bj][n] * acc[ai][bj][m][n]; }
                asm volatile("" ::: "memory"); }
    }
};
struct PolMoe1 {
    static constexpr int MODE = 1; static constexpr bool PERM = true;
    int K; const char* A; const char* B; const int* lista; const float* listw; MoeOrder ord; bf16_t* act;
    __device__ bool next(int i, Unit& u) const { return ord.next(i, u); }
    __device__ __forceinline__ void epi(const f32x4 (&acc)[2][2][4][2], const Unit& u, const LAS int*, const LAS float* tW) const {
        const int tz = tid_l(), wid = tz >> 6, lane = tz & 63, wr = wid >> 2, wc = wid & 3, fr = lane & 15, fq = lane >> 4;
        const int col0 = u.pn * HALF + wc * 32 + 8 * fq;
#pragma unroll
        for (int ai = 0; ai < 2; ++ai)
#pragma unroll
            for (int m = 0; m < 4; ++m) { const int rl = ai * HALF + wr * 64 + m * 16 + fr; const float w = tW[rl];
                float o[8];
#pragma unroll
                for (int n = 0; n < 2; ++n)
#pragma unroll
                    for (int j = 0; j < 4; ++j) o[n * 4 + j] = silu_f(acc[ai][0][m][n][j]) * acc[ai][1][m][n][j] * w;
                *(u32x4*)(act + (size_t)(u.orow + rl) * DFF + col0) = pack8(o); }
    }
};
struct PolMoe2 {
    static constexpr int MODE = 2; static constexpr bool PERM = true;
    int K; const char* A; const char* B; const int* lista; const float* listw; MoeOrder ord; bf16_t* ymoe;
    __device__ bool next(int i, Unit& u) const { return ord.next(i, u); }
    __device__ __forceinline__ void epi(const f32x4 (&acc)[2][2][4][2], const Unit& u, const LAS int* tA, const LAS float*) const {
        const int tz = tid_l(), wid = tz >> 6, lane = tz & 63, wr = wid >> 2, wc = wid & 3, fr = lane & 15, fq = lane >> 4;
        const int col0 = u.pn * BM + wc * 32 + 8 * fq;
#pragma unroll
        for (int ai = 0; ai < 2; ++ai)
#pragma unroll
            for (int m = 0; m < 4; ++m) { const int rl = ai * HALF + wr * 64 + m * 16 + fr; const int a = tA[rl];
                if (rl < u.nvalid) { bf16_t* rowp = ymoe + (size_t)a * D + col0;
#pragma unroll
                    for (int bj = 0; bj < 2; ++bj) { const f32x4 v0 = acc[ai][bj][m][0], v1 = acc[ai][bj][m][1];
                        u32x4 w; w.x = cvt_pk_bf16(v0[0], v0[1]); w.y = cvt_pk_bf16(v0[2], v0[3]); w.z = cvt_pk_bf16(v1[0], v1[1]); w.w = cvt_pk_bf16(v1[2], v1[3]);
                        *(u32x4*)(rowp + bj * HALF) = w; } } }
    }
};

struct Params { const float* in[23]; float* out; unsigned char* ws; int ph_lo, ph_hi; };
struct Frame { LAS unsigned char* lds; int wg, G; unsigned char* ws; };
__device__ __forceinline__ unsigned char* wsl(const Frame& F) { unsigned char* w = F.ws; asm volatile("" : "+s"(w)); return w; }
#define WSP(T, w, off) ((T*)((w) + (off)))

struct PrepPtrs { const float *w_in, *w_out, *w_gate, *w_up, *w_down; bf16_t *win, *wout, *wgu, *wdn; };
__device__ __forceinline__ void prep_decode(int task, const PrepPtrs& Q, const float*& src, bf16_t*& dst, int& N, int& Kd, int& n0, int& k0, int& nlim, int& mode) {
    if (task < 576) { const int l = task / 144, r = task % 144; src = Q.w_in + (size_t)l * D * D_IN; dst = Q.win + (size_t)l * ZLD * D; N = D_IN; Kd = D; n0 = (r / 16) * 256; k0 = (r % 16) * 64; nlim = D_IN; mode = 0; }
    else if (task < 832) { const int q = task - 576, l = q / 64, r = q % 64; src = Q.w_out + (size_t)l * D * D; dst = Q.wout + (size_t)l * D * D; N = D; Kd = D; n0 = (r / 16) * 256; k0 = (r % 16) * 64; nlim = D; mode = 0; }
    else if (task < 4928) { const int q = task - 832, mat = q / 32, r = q % 32; src = Q.w_gate + (size_t)mat * D * DFF; dst = Q.wgu + (size_t)mat * 1024 * 1024; N = DFF; Kd = D; n0 = (r / 16) * 256; k0 = (r % 16) * 64; nlim = DFF; mode = 1; }
    else if (task < 9024) { const int q = task - 4928, mat = q / 32, r = q % 32; src = Q.w_up + (size_t)mat * D * DFF; dst = Q.wgu + (size_t)mat * 1024 * 1024; N = DFF; Kd = D; n0 = (r / 16) * 256; k0 = (r % 16) * 64; nlim = DFF; mode = 2; }
    else { const int q = task - 9024, mat = q / 32, r = q % 32; src = Q.w_down + (size_t)mat * DFF * D; dst = Q.wdn + (size_t)mat * 1024 * DFF; N = D; Kd = DFF; n0 = (r / 8) * 256; k0 = (r % 8) * 64; nlim = D; mode = 0; }
}
constexpr int PREP_TASKS = 13120;
__device__ __forceinline__ void prep_load(const float* src, int N, int n0, int k0, int nlim, int wave, int lane, f32x4 (&v)[8]) {
    const int n = n0 + 4 * lane; const bool ok = n < nlim;
    const float* p = src + (size_t)(k0 + wave * 8) * N + n;
#pragma unroll
    for (int q = 0; q < 8; ++q) v[q] = ok ? *(const f32x4*)(p + (size_t)q * N) : (f32x4){0.f, 0.f, 0.f, 0.f};
}
__device__ __forceinline__ void prep_store(bf16_t* dst, int Kd, int n0, int k0, int nlim, int mode, int wave, int lane, const f32x4 (&v)[8]) {
    const int n = n0 + 4 * lane; if (n >= nlim) return;
#pragma unroll
    for (int cc = 0; cc < 4; ++cc) { const int f = n + cc; const int row = mode == 0 ? f : ((f >> 7) * 256 + (f & 127) + (mode == 2 ? 128 : 0));
        u32x4 w; w.x = cvt_pk_bf16(v[0][cc], v[1][cc]); w.y = cvt_pk_bf16(v[2][cc], v[3][cc]); w.z = cvt_pk_bf16(v[4][cc], v[5][cc]); w.w = cvt_pk_bf16(v[6][cc], v[7][cc]);
        *(u32x4*)(dst + (size_t)row * Kd + k0 + wave * 8) = w; }
}
__device__ __forceinline__ void copy_f32(float* dst, const float* src, int n, int gtid, int gn) { for (int i = gtid; i < n; i += gn) dst[i] = src[i]; }
__device__ __forceinline__ void phase_prep(const Frame& F, const Params& p) {
    const int tid = tid_l(), lane = tid & 63, wave = __builtin_amdgcn_readfirstlane(tid >> 6), wg = F.wg;
    unsigned char* ws = wsl(F);
    {
        const float* c_in = p.in[1]; const float* w_ada = p.in[2]; const float* b_ada = p.in[3]; float* ada = WSP(float, ws, WS_ADA);
        LAS float* cs = (LAS float*)F.lds;
        LAS float* part = (LAS float*)(F.lds + 32768);
        for (int i = tid; i < NB * D; i += NTHR) { const int b = i >> 10, k = i & 1023; const float v = c_in[i]; cs[k * 8 + b] = v / (1.f + __expf(-v)); }
        __syncthreads();
        const int l = wg >> 6, j0 = (wg & 63) * 96, ks = lane >> 5, cq = lane & 31;
        if (cq < 24) {
            f32x4 acc[8];
#pragma unroll
            for (int b = 0; b < 8; ++b) acc[b] = (f32x4){0.f, 0.f, 0.f, 0.f};
            const float* wp = w_ada + ((size_t)l * D + wave * 128 + ks) * 6144 + j0 + 4 * cq;
#pragma unroll 8
            for (int i = 0; i < 64; ++i) {
                const f32x4 w4 = *(const f32x4*)(wp + (size_t)(2 * i) * 6144);
                const int k = wave * 128 + 2 * i + ks;
                const f32x4 c0 = *(const LAS f32x4*)(cs + k * 8), c1 = *(const LAS f32x4*)(cs + k * 8 + 4);
                acc[0] += w4 * c0[0]; acc[1] += w4 * c0[1]; acc[2] += w4 * c0[2]; acc[3] += w4 * c0[3];
                acc[4] += w4 * c1[0]; acc[5] += w4 * c1[1]; acc[6] += w4 * c1[2]; acc[7] += w4 * c1[3];
            }
#pragma unroll
            for (int b = 0; b < 8; ++b) *(LAS f32x4*)(part + ((wave * 2 + ks) * 8 + b) * 96 + 4 * cq) = acc[b];
        }
        __syncthreads();
        for (int o = tid; o < 768; o += NTHR) { const int b = o / 96, j = o % 96; float s = 0.f;
#pragma unroll
            for (int q = 0; q < 16; ++q) s += part[(q * 8 + b) * 96 + j];
            ada[((size_t)l * NB + b) * 6144 + j0 + j] = s + b_ada[l * 6144 + j0 + j]; }
        __syncthreads();
    }
    const int gtid = wg * NTHR + tid, gn = F.G * NTHR;
    {
        const float* w_router = p.in[16]; float* wrt = WSP(float, ws, WS_WRT);
        for (int i = gtid; i < NE * D; i += gn) { const int e = i >> 10, k = i & 1023; wrt[i] = w_router[k * NE + e]; }
        const float* sgu_w = p.in[11]; bf16_t* sguw = WSP(bf16_t, ws, WS_SGUW);
        for (int i = gtid; i < DEPTH * 6 * 128 * 128; i += gn) { const int sx = i & 127, t = (i >> 7) & 127; sguw[i] = (bf16_t)(cvt_pk_bf16(sx <= t ? sgu_w[i] : 0.f, 0.f) & 0xffffu); }
        const float* pool_w = p.in[7]; bf16_t* poolw = WSP(bf16_t, ws, WS_POOLW);
        for (int i = gtid; i < DEPTH * 4 * 64 * 64; i += gn) { const int cc = i & 63, d = (i >> 6) & 63, lg = i >> 12; poolw[i] = (bf16_t)(cvt_pk_bf16(pool_w[(lg * 64 + cc) * 64 + d], 0.f) & 0xffffu); }
        bf16_t* win = WSP(bf16_t, ws, WS_WIN);
        for (int i = gtid; i < DEPTH * 128 * 128; i += gn) { const int l = i >> 14, r = i & 16383; *(u32x4*)(win + ((size_t)l * ZLD + D_IN) * D + (size_t)r * 8) = (u32x4){0u, 0u, 0u, 0u}; }
        float* sm = WSP(float, ws, WS_SMALL);
        copy_f32(sm + SM_CONVW, p.in[5], 4608, gtid, gn); copy_f32(sm + SM_CONVB, p.in[6], 1536, gtid, gn); copy_f32(sm + SM_PSCALE, p.in[8], 1024, gtid, gn);
        copy_f32(sm + SM_LNG, p.in[9], 1536, gtid, gn); copy_f32(sm + SM_LNB, p.in[10], 1536, gtid, gn); copy_f32(sm + SM_SGUB, p.in[12], 3072, gtid, gn);
        copy_f32(sm + SM_LN1G, p.in[14], 4096, gtid, gn); copy_f32(sm + SM_LN1B, p.in[15], 4096, gtid, gn); copy_f32(sm + SM_LN2G, p.in[21], 4096, gtid, gn); copy_f32(sm + SM_LN2B, p.in[22], 4096, gtid, gn);
        copy_f32(sm + SM_BR, p.in[17], 32, gtid, gn);
    }
    PrepPtrs Q; Q.w_in = p.in[4]; Q.w_out = p.in[13]; Q.w_gate = p.in[18]; Q.w_up = p.in[19]; Q.w_down = p.in[20];
    Q.win = WSP(bf16_t, ws, WS_WIN); Q.wout = WSP(bf16_t, ws, WS_WOUT); Q.wgu = WSP(bf16_t, ws, WS_WGU); Q.wdn = WSP(bf16_t, ws, WS_WDN);
    for (int t0 = wg; t0 < PREP_TASKS; t0 += 2 * F.G) {
        const int t1 = t0 + F.G; const bool two = t1 < PREP_TASKS;
        const float* s0; bf16_t* d0; int N0, K0, n00, k00, nl0, m0; prep_decode(t0, Q, s0, d0, N0, K0, n00, k00, nl0, m0);
        const float* s1 = s0; bf16_t* d1 = d0; int N1 = N0, K1 = K0, n01 = n00, k01 = k00, nl1 = nl0, m1 = m0;
        if (two) prep_decode(t1, Q, s1, d1, N1, K1, n01, k01, nl1, m1);
        f32x4 va[8], vb[8];
        prep_load(s0, N0, n00, k00, nl0, wave, lane, va);
        if (two) prep_load(s1, N1, n01, k01, nl1, wave, lane, vb);
        prep_store(d0, K0, n00, k00, nl0, m0, wave, lane, va);
        if (two) prep_store(d1, K1, n01, k01, nl1, m1, wave, lane, vb);
    }
}
__device__ __forceinline__ void phase_h0(const Frame& F, const float* x) {
    unsigned char* ws = wsl(F);
    const float* ada = WSP(const float, ws, WS_ADA); bf16_t* hb = WSP(bf16_t, ws, WS_H);
    const int gtid = F.wg * NTHR + tid_l(), gn = F.G * NTHR;
    for (int v = gtid; v < T * D / 8; v += gn) {
        const int tok = v >> 7, c = (v & 127) * 8, b = tok / SEQ;
        const float* xp = x + (size_t)tok * D + c; const float* ap = ada + (size_t)b * 6144 + c;
        const f32x4 x0 = *(const f32x4*)xp, x1 = *(const f32x4*)(xp + 4), sh0 = *(const f32x4*)ap, sh1 = *(const f32x4*)(ap + 4), sc0 = *(const f32x4*)(ap + 1024), sc1 = *(const f32x4*)(ap + 1028);
        const f32x4 h0 = x0 * (sc0 + 1.0f) + sh0, h1 = x1 * (sc1 + 1.0f) + sh1;
        u32x4 w; w.x = cvt_pk_bf16(h0[0], h0[1]); w.y = cvt_pk_bf16(h0[2], h0[3]); w.z = cvt_pk_bf16(h1[0], h1[1]); w.w = cvt_pk_bf16(h1[2], h1[3]);
        *(u32x4*)(hb + (size_t)tok * D + c) = w;
    }
}

__device__ __forceinline__ u16x4 tr_read(unsigned lds_addr) { u16x4 r; asm volatile("ds_read_b64_tr_b16 %0, %1\n\ts_waitcnt lgkmcnt(0)" : "=&v"(r) : "v"(lds_addr) : "memory"); return r; }

__device__ __forceinline__ void mixer_conv(const Frame& F, unsigned char* ws, int l, int tok0, int n) {
    const int tid = tid_l();
    const bf16_t* zb = WSP(const bf16_t, ws, WS_Z); bf16_t* yb = WSP(bf16_t, ws, WS_Y); const float* sm = WSP(const float, ws, WS_SMALL);
    if (tid < 480) {
        const int cv = tid % 48, tseg = tid / 48, tb = tseg * 13, te = (tb + 13) < 128 ? (tb + 13) : 128;
        const float* cw = sm + SM_CONVW + (size_t)l * 3 * CONV_W + cv * 8; const float* cb = sm + SM_CONVB + (size_t)l * CONV_W + cv * 8;
        float w0[8], w1[8], w2[8], bb[8];
#pragma unroll
        for (int j = 0; j < 8; ++j) { w0[j] = cw[j]; w1[j] = cw[CONV_W + j]; w2[j] = cw[2 * CONV_W + j]; bb[j] = cb[j]; }
        const bf16_t* zr = zb + (size_t)(tok0 + tb) * ZLD + cv * 8;
        const int pos = n * CHUNK + tb;
        float q1[8], q2[8];
#pragma unroll
        for (int j = 0; j < 8; ++j) { q1[j] = 0.f; q2[j] = 0.f; }
        if (pos >= 1) { float a[8], b[8]; unpack8(*(const u32x4*)(zr - ZLD + OFF_GC), a); unpack8(*(const u32x4*)(zr - ZLD + OFF_XC), b);
#pragma unroll
            for (int j = 0; j < 8; ++j) q1[j] = a[j] * b[j]; }
        if (pos >= 2) { float a[8], b[8]; unpack8(*(const u32x4*)(zr - 2 * ZLD + OFF_GC), a); unpack8(*(const u32x4*)(zr - 2 * ZLD + OFF_XC), b);
#pragma unroll
            for (int j = 0; j < 8; ++j) q2[j] = a[j] * b[j]; }
        for (int t = tb; t < te; ++t) {
            float g[8], a[8], b[8], o[8];
            unpack8(*(const u32x4*)(zr + OFF_GB), g); unpack8(*(const u32x4*)(zr + OFF_GC), a); unpack8(*(const u32x4*)(zr + OFF_XC), b);
#pragma unroll
            for (int j = 0; j < 8; ++j) { const float q0 = a[j] * b[j]; o[j] = g[j] * (w0[j] * q2[j] + w1[j] * q1[j] + w2[j] * q0 + bb[j]); q2[j] = q1[j]; q1[j] = q0; }
            *(u32x4*)(yb + (size_t)(tok0 + t) * D + cv * 8) = pack8(o);
            zr += ZLD;
        }
    }
}
constexpr int PL_LD = 264;
__device__ __forceinline__ void mixer_pool(const Frame& F, unsigned char* ws, int l, int tok0, int n) {
    const int tid = tid_l(), lane = tid & 63, wave = __builtin_amdgcn_readfirstlane(tid >> 6);
    const bf16_t* zb = WSP(const bf16_t, ws, WS_Z); bf16_t* yb = WSP(bf16_t, ws, WS_Y); const float* sm = WSP(const float, ws, WS_SMALL);
    LAS bf16_t* PL = (LAS bf16_t*)F.lds;
    {
        const int cv = tid & 31, seg = tid >> 5, g = cv >> 3, win = 2 << g;
        const int pos0 = n * CHUNK + seg * 8;
        const bf16_t* pr = zb + (size_t)(tok0 + seg * 8) * ZLD + OFF_P + cv * 8;
        float S[8];
#pragma unroll
        for (int j = 0; j < 8; ++j) S[j] = 0.f;
        for (int k = 1; k < win; ++k) if (pos0 - k >= 0) { float a[8]; unpack8(*(const u32x4*)(pr - (size_t)k * ZLD), a);
#pragma unroll
            for (int j = 0; j < 8; ++j) S[j] += a[j]; }
        for (int t = 0; t < 8; ++t) {
            const int pos = pos0 + t; float pv[8], o[8]; unpack8(*(const u32x4*)(pr + (size_t)t * ZLD), pv);
            const float inv = 1.0f / (float)((pos + 1) < win ? (pos + 1) : win);
#pragma unroll
            for (int j = 0; j < 8; ++j) { S[j] += pv[j]; o[j] = S[j] * inv - pv[j]; }
            *(LAS u32x4*)(PL + (seg * 8 + t) * PL_LD + cv * 8) = pack8(o);
            if (pos - win + 1 >= 0) { float a[8]; unpack8(*(const u32x4*)(pr + (ptrdiff_t)(t - win + 1) * ZLD), a);
#pragma unroll
                for (int j = 0; j < 8; ++j) S[j] -= a[j]; }
        }
    }
    __syncthreads();
    {
        const int fr = lane & 15, fq = lane >> 4, t0 = wave * 16;
        const bf16_t* wt = WSP(const bf16_t, ws, WS_POOLW) + (size_t)l * 4 * 64 * 64;
        const float* sc = sm + SM_PSCALE + (size_t)l * POOL_W;
#pragma unroll
        for (int g = 0; g < 4; ++g) {
            bf16x8 yf[2];
#pragma unroll
            for (int ks = 0; ks < 2; ++ks) yf[ks] = *(const LAS bf16x8*)(PL + (t0 + fr) * PL_LD + g * 64 + ks * 32 + fq * 8);
#pragma unroll
            for (int db = 0; db < 4; ++db) {
                f32x4 acc = (f32x4){0.f, 0.f, 0.f, 0.f};
#pragma unroll
                for (int ks = 0; ks < 2; ++ks) { const bf16x8 xf = *(const bf16x8*)(wt + ((size_t)(g * 64 + db * 16 + fr)) * 64 + ks * 32 + fq * 8);
                    acc = __builtin_amdgcn_mfma_f32_16x16x32_bf16(xf, yf[ks], acc, 0, 0, 0); }
                const int d = db * 16 + 4 * fq; const f32x4 s4 = *(const f32x4*)(sc + g * 64 + d);
                u32x2 w; w.x = cvt_pk_bf16(acc[0] * s4[0], acc[1] * s4[1]); w.y = cvt_pk_bf16(acc[2] * s4[2], acc[3] * s4[3]);
                *(u32x2*)(yb + (size_t)(tok0 + t0 + fr) * D + CONV_W + g * 64 + d) = w;
            }
        }
    }
    __syncthreads();
}
constexpr int VN_LD = 200;
__device__ __forceinline__ void mixer_sgu(const Frame& F, unsigned char* ws, int l, int tok0, int h0) {
    const int tid = tid_l(), lane = tid & 63, wave = __builtin_amdgcn_readfirstlane(tid >> 6);
    const bf16_t* zb = WSP(const bf16_t, ws, WS_Z); bf16_t* yb = WSP(bf16_t, ws, WS_Y); const float* sm = WSP(const float, ws, WS_SMALL);
    LAS bf16_t* VN = (LAS bf16_t*)F.lds;
    {
        const int tk = lane >> 4, li = lane & 15;
        const float* gp = sm + SM_LNG + (size_t)l * SGU_W; const float* bp = sm + SM_LNB + (size_t)l * SGU_W;
        for (int it = 0; it < 4; ++it) {
            const int t = wave * 16 + it * 4 + tk;
            const bf16_t* vr = zb + (size_t)(tok0 + t) * ZLD + OFF_V;
            float v[3][8]; float s = 0.f;
#pragma unroll
            for (int j = 0; j < 3; ++j) { unpack8(*(const u32x4*)(vr + (li + 16 * j) * 8), v[j]);
#pragma unroll
                for (int q = 0; q < 8; ++q) s += v[j][q]; }
            s += __shfl_xor(s, 1); s += __shfl_xor(s, 2); s += __shfl_xor(s, 4); s += __shfl_xor(s, 8);
            const float mu = s * (1.0f / SGU_W); float qq = 0.f;
#pragma unroll
            for (int j = 0; j < 3; ++j)
#pragma unroll
                for (int q = 0; q < 8; ++q) { const float d = v[j][q] - mu; qq += d * d; }
            qq += __shfl_xor(qq, 1); qq += __shfl_xor(qq, 2); qq += __shfl_xor(qq, 4); qq += __shfl_xor(qq, 8);
            const float rs = rsqrtf(qq * (1.0f / SGU_W) + LN_EPS);
#pragma unroll
            for (int j = 0; j < 3; ++j) { const int cvv = li + 16 * j;
                if (cvv >= 8 * h0 && cvv < 8 * h0 + 24) { float o[8];
#pragma unroll
                    for (int q = 0; q < 8; ++q) o[q] = (v[j][q] - mu) * rs * gp[cvv * 8 + q] + bp[cvv * 8 + q];
                    *(LAS u32x4*)(VN + t * VN_LD + (cvv - 8 * h0) * 8) = pack8(o); } }
        }
    }
    __syncthreads();
    {
        const int fr = lane & 15, fq = lane >> 4, t0 = wave * 16, nks = (wave >> 1) + 1;
        const unsigned vn_base = (unsigned)(size_t)VN;
        const int q = fr >> 2, pp = fr & 3;
        const bf16_t* sguw = WSP(const bf16_t, ws, WS_SGUW);
#pragma unroll
        for (int hh = 0; hh < 3; ++hh) {
            const int h = h0 + hh;
            const bf16_t* wsp = sguw + ((size_t)(l * 6 + h) * 128 + t0 + fr) * 128 + fq * 8;
            const float bias = sm[SM_SGUB + (l * 6 + h) * 128 + t0 + fr];
#pragma unroll
            for (int db = 0; db < 4; ++db) {
                f32x4 acc = (f32x4){0.f, 0.f, 0.f, 0.f};
                for (int ks = 0; ks < nks; ++ks) {
                    const unsigned a0 = vn_base + (unsigned)((ks * 32 + 8 * fq + q) * VN_LD + hh * 64 + db * 16 + 4 * pp) * 2u;
                    const u16x4 lo = tr_read(a0), hi = tr_read(a0 + 4u * VN_LD * 2u);
                    bf16x8 xf; xf[0] = (short)lo[0]; xf[1] = (short)lo[1]; xf[2] = (short)lo[2]; xf[3] = (short)lo[3]; xf[4] = (short)hi[0]; xf[5] = (short)hi[1]; xf[6] = (short)hi[2]; xf[7] = (short)hi[3];
                    const bf16x8 yf = *(const bf16x8*)(wsp + ks * 32);
                    acc = __builtin_amdgcn_mfma_f32_16x16x32_bf16(xf, yf, acc, 0, 0, 0);
                }
                const int d = db * 16 + 4 * fq;
                const u32x2 uu = *(const u32x2*)(zb + (size_t)(tok0 + t0 + fr) * ZLD + OFF_U + h * 64 + d);
                u32x2 w; w.x = cvt_pk_bf16(bf_lo(uu.x) * (acc[0] + bias), bf_hi(uu.x) * (acc[1] + bias)); w.y = cvt_pk_bf16(bf_lo(uu.y) * (acc[2] + bias), bf_hi(uu.y) * (acc[3] + bias));
                *(u32x2*)(yb + (size_t)(tok0 + t0 + fr) * D + CONV_W + POOL_W + h * 64 + d) = w;
            }
        }
    }
    __syncthreads();
}
__device__ __forceinline__ void phase_mixer(const Frame& F, int l) {
    unsigned char* ws = wsl(F);
    for (int u = F.wg; u < 512; u += F.G) {
        const int part = u >> 7, bn = u & 127, tok0 = bn * CHUNK, n = bn & 15;
        if (part == 0) mixer_conv(F, ws, l, tok0, n);
        else if (part == 1) mixer_pool(F, ws, l, tok0, n);
        else mixer_sgu(F, ws, l, tok0, part == 2 ? 0 : 3);
    }
}

__device__ __forceinline__ void phase_ln1_router(const Frame& F, int l) {
    const int tid = tid_l(), lane = tid & 63, wave = __builtin_amdgcn_readfirstlane(tid >> 6), wg = F.wg;
    unsigned char* ws = wsl(F);
    float* xres = WSP(float, ws, WS_X); bf16_t* hb = WSP(bf16_t, ws, WS_H); const float* sm = WSP(const float, ws, WS_SMALL);
    LAS float* wrt = (LAS float*)F.lds;
    LAS int* hist = (LAS int*)(F.lds + MISC_OFF + 16);
    LAS int* base = hist + 32;
    LAS int* asg_e = base + 32; LAS int* asg_r = asg_e + 128; LAS float* asg_w = (LAS float*)(asg_r + 128);
    { const float* wrt_g = WSP(const float, ws, WS_WRT);
      for (int i = tid; i < NE * D / 4; i += NTHR) *(LAS f32x4*)(wrt + i * 4) = *(const f32x4*)(wrt_g + (size_t)i * 4); }
    if (tid < 32) hist[tid] = 0;
    __syncthreads();
    const float* ada_l = WSP(const float, ws, WS_ADA) + (size_t)l * NB * 6144;
    const float* lgp = sm + SM_LN1G + (size_t)l * D + 4 * lane; const float* lbp = sm + SM_LN1B + (size_t)l * D + 4 * lane;
    for (int tg = wg; tg < T / 64; tg += F.G) {
        const int tokb = tg * 64, b = tokb / SEQ;
        const float* shp = ada_l + (size_t)b * 6144 + 3072 + 4 * lane; const float* scp = shp + 1024;
        for (int pass = 0; pass < 4; ++pass) {
            f32x4 hv[2][4];
#pragma unroll
            for (int tk = 0; tk < 2; ++tk) {
                const int tok = tokb + wave * 8 + pass * 2 + tk;
                float* xr = xres + (size_t)tok * D + 4 * lane;
                f32x4 v[4]; float s = 0.f;
#pragma unroll
                for (int j = 0; j < 4; ++j) { v[j] = *(const f32x4*)(xr + 256 * j); s += (v[j][0] + v[j][1]) + (v[j][2] + v[j][3]); }
                s = wave_sum(s); const float mu = s * (1.0f / D); float q = 0.f;
#pragma unroll
                for (int j = 0; j < 4; ++j) { const f32x4 d = v[j] - mu; q += (d[0] * d[0] + d[1] * d[1]) + (d[2] * d[2] + d[3] * d[3]); }
                q = wave_sum(q); const float rs = rsqrtf(q * (1.0f / D) + LN_EPS);
#pragma unroll
                for (int j = 0; j < 4; ++j) { const f32x4 xn = (v[j] - mu) * rs * *(const f32x4*)(lgp + 256 * j) + *(const f32x4*)(lbp + 256 * j); *(f32x4*)(xr + 256 * j) = xn;
                    const f32x4 hh = xn * (*(const f32x4*)(scp + 256 * j) + 1.0f) + *(const f32x4*)(shp + 256 * j); hv[tk][j] = hh;
                    u32x2 w; w.x = cvt_pk_bf16(hh[0], hh[1]); w.y = cvt_pk_bf16(hh[2], hh[3]);
                    *(u32x2*)(hb + (size_t)tok * D + 256 * j + 4 * lane) = w; }
            }
            float pa[64];
#pragma unroll
            for (int e = 0; e < 32; ++e) { float a0 = 0.f, a1 = 0.f;
#pragma unroll
                for (int j = 0; j < 4; ++j) { const f32x4 w4 = *(const LAS f32x4*)(wrt + e * D + 256 * j + 4 * lane);
                    a0 += hv[0][j][0] * w4[0] + hv[0][j][1] * w4[1] + hv[0][j][2] * w4[2] + hv[0][j][3] * w4[3];
                    a1 += hv[1][j][0] * w4[0] + hv[1][j][1] * w4[1] + hv[1][j][2] * w4[2] + hv[1][j][3] * w4[3]; }
                pa[e] = a0; pa[32 + e] = a1; }
#pragma unroll
            for (int i = 0; i < 32; ++i) { const float snd = (lane & 32) ? pa[i] : pa[32 + i], kp = (lane & 32) ? pa[32 + i] : pa[i]; pa[i] = kp + __shfl_xor(snd, 32); }
#pragma unroll
            for (int i = 0; i < 16; ++i) { const float snd = (lane & 16) ? pa[i] : pa[16 + i], kp = (lane & 16) ? pa[16 + i] : pa[i]; pa[i] = kp + __shfl_xor(snd, 16); }
#pragma unroll
            for (int i = 0; i < 8; ++i) { const float snd = (lane & 8) ? pa[i] : pa[8 + i], kp = (lane & 8) ? pa[8 + i] : pa[i]; pa[i] = kp + __shfl_xor(snd, 8); }
#pragma unroll
            for (int i = 0; i < 4; ++i) { const float snd = (lane & 4) ? pa[i] : pa[4 + i], kp = (lane & 4) ? pa[4 + i] : pa[i]; pa[i] = kp + __shfl_xor(snd, 4); }
#pragma unroll
            for (int i = 0; i < 2; ++i) { const float snd = (lane & 2) ? pa[i] : pa[2 + i], kp = (lane & 2) ? pa[2 + i] : pa[i]; pa[i] = kp + __shfl_xor(snd, 2); }
            { const float snd = (lane & 1) ? pa[0] : pa[1], kp = (lane & 1) ? pa[1] : pa[0]; pa[0] = kp + __shfl_xor(snd, 1); }
            const int e_me = lane & 31;
            const float logit = pa[0] + sm[SM_BR + e_me];
            float mx = logit;
#pragma unroll
            for (int o = 16; o; o >>= 1) mx = fmaxf(mx, __shfl_xor(mx, o));
            const float ex = __expf(logit - mx); float smm = ex;
#pragma unroll
            for (int o = 16; o; o >>= 1) smm += __shfl_xor(smm, o);
            const float pr = ex / smm;
            int rank = 0;
#pragma unroll
            for (int k = 1; k < 8; ++k) { const float po = __shfl_xor(pr, k); const int jo = (e_me ^ k); rank += (po > pr || (po == pr && jo < e_me)) ? 1 : 0; }
            float gsc = rank < 2 ? pr : 0.f;
            gsc += __shfl_xor(gsc, 1); gsc += __shfl_xor(gsc, 2); gsc += __shfl_xor(gsc, 4);
            int gsel = 0; float best = -1.f;
#pragma unroll
            for (int g = 0; g < 4; ++g) { const float sg = __shfl(gsc, (lane & 32) + 8 * g); if (sg > best) { best = sg; gsel = g; } }
            const bool ing = (e_me >> 3) == gsel;
            const unsigned long long m0 = __ballot(ing && rank == 0), m1 = __ballot(ing && rank == 1);
            const unsigned h0m = (unsigned)(m0 >> (lane & 32)), h1m = (unsigned)(m1 >> (lane & 32));
            const int e0 = __ffs(h0m) - 1, e1 = __ffs(h1m) - 1;
            const float p0 = __shfl(pr, (lane & 32) + e0), p1 = __shfl(pr, (lane & 32) + e1);
            if ((lane & 31) < 2) {
                const int k = lane & 1, tk = lane >> 5, e = k ? e1 : e0; const float w = (k ? p1 : p0) / (p0 + p1);
                const int al = (wave * 8 + pass * 2 + tk) * 2 + k;
                asg_e[al] = e; asg_w[al] = w; asg_r[al] = atomicAdd((int*)(hist + e), 1);
            }
        }
        __syncthreads();
        unsigned* cnt = WSP(unsigned, ws, WS_CTL + CTL_CNT);
        if (tid < 32) { const int hc = hist[tid]; base[tid] = hc ? (int)__hip_atomic_fetch_add(cnt + l * 32 + tid, (unsigned)hc, __ATOMIC_RELAXED, __HIP_MEMORY_SCOPE_AGENT) : 0; }
        __syncthreads();
        if (tid < 128) { const int e = asg_e[tid], pos = base[e] + asg_r[tid]; WSP(int, ws, WS_LISTA)[e * LCAP + pos] = (tokb + (tid >> 1)) * 2 + (tid & 1); WSP(float, ws, WS_LISTW)[e * LCAP + pos] = asg_w[tid]; }
        __syncthreads();
        if (tid < 32) hist[tid] = 0;
        __syncthreads();
    }
}

__device__ __forceinline__ void phase_ln2(const Frame& F, int l, float* out) {
    const int tid = tid_l(), lane = tid & 63, wave = __builtin_amdgcn_readfirstlane(tid >> 6), wg = F.wg;
    unsigned char* ws = wsl(F);
    const bool lastl = (l == DEPTH - 1);
    const float* sm = WSP(const float, ws, WS_SMALL);
    const float* ada_l = WSP(const float, ws, WS_ADA) + (size_t)l * NB * 6144; const float* ada_n = WSP(const float, ws, WS_ADA) + (size_t)(lastl ? l : l + 1) * NB * 6144;
    const float* xres = WSP(const float, ws, WS_X); const bf16_t* ymoe = WSP(const bf16_t, ws, WS_YMOE); bf16_t* hb = WSP(bf16_t, ws, WS_H);
    float* dst = lastl ? out : WSP(float, ws, WS_X);
    const float* lgp = sm + SM_LN2G + (size_t)l * D + 4 * lane; const float* lbp = sm + SM_LN2B + (size_t)l * D + 4 * lane;
    for (int tg = wg; tg < T / 64; tg += F.G) {
        const int tokb = tg * 64, b = tokb / SEQ;
        const float* g2p = ada_l + (size_t)b * 6144 + 5120 + 4 * lane; const float* shp = ada_n + (size_t)b * 6144 + 4 * lane; const float* scp = shp + 1024;
        for (int pass = 0; pass < 8; ++pass) {
            const int tok = tokb + wave * 8 + pass;
            const float* xr = xres + (size_t)tok * D + 4 * lane;
            const bf16_t* y0 = ymoe + (size_t)(2 * tok) * D + 4 * lane; const bf16_t* y1 = y0 + D;
            f32x4 v[4]; float s = 0.f;
#pragma unroll
            for (int j = 0; j < 4; ++j) { const f32x4 xv = *(const f32x4*)(xr + 256 * j); const u32x2 a = *(const u32x2*)(y0 + 256 * j), c = *(const u32x2*)(y1 + 256 * j);
                f32x4 ys; ys[0] = bf_lo(a.x) + bf_lo(c.x); ys[1] = bf_hi(a.x) + bf_hi(c.x); ys[2] = bf_lo(a.y) + bf_lo(c.y); ys[3] = bf_hi(a.y) + bf_hi(c.y);
                v[j] = xv * ALPHA + *(const f32x4*)(g2p + 256 * j) * ys; s += (v[j][0] + v[j][1]) + (v[j][2] + v[j][3]); }
            s = wave_sum(s); const float mu = s * (1.0f / D); float q = 0.f;
#pragma unroll
            for (int j = 0; j < 4; ++j) { const f32x4 d = v[j] - mu; q += (d[0] * d[0] + d[1] * d[1]) + (d[2] * d[2] + d[3] * d[3]); }
            q = wave_sum(q); const float rs = rsqrtf(q * (1.0f / D) + LN_EPS);
#pragma unroll
            for (int j = 0; j < 4; ++j) { const f32x4 xn = (v[j] - mu) * rs * *(const f32x4*)(lgp + 256 * j) + *(const f32x4*)(lbp + 256 * j); *(f32x4*)(dst + (size_t)tok * D + 256 * j + 4 * lane) = xn;
                if (!lastl) { const f32x4 hh = xn * (*(const f32x4*)(scp + 256 * j) + 1.0f) + *(const f32x4*)(shp + 256 * j); u32x2 w; w.x = cvt_pk_bf16(hh[0], hh[1]); w.y = cvt_pk_bf16(hh[2], hh[3]);
                    *(u32x2*)(hb + (size_t)tok * D + 256 * j + 4 * lane) = w; } }
        }
    }
}

__device__ __forceinline__ int moe_sched(const Frame& F, unsigned char* ws, int l) {
    LAS int* sc = (LAS int*)(F.lds + SCHED_OFF);
    const int tid = tid_l();
    if (tid < 32) sc[tid] = (int)__hip_atomic_load(WSP(unsigned, ws, WS_CTL + CTL_CNT) + l * 32 + tid, __ATOMIC_RELAXED, __HIP_MEMORY_SCOPE_AGENT);
    __syncthreads();
    if (tid == 0) { int a = 0; for (int e = 0; e < 32; ++e) { sc[32 + e] = a; a += (sc[e] + 255) >> 8; } sc[64] = a; }
    __syncthreads();
    const int NT = sc[64];
    for (int tl = tid; tl < NT; tl += NTHR) { int e = 0; for (int k = 1; k < 32; ++k) e = (sc[32 + k] <= tl) ? k : e; sc[96 + tl] = e; }
    __syncthreads();
    return NT;
}

constexpr int N_PHASES = 2 + 7 * DEPTH;
#ifndef PH_MASK
#define PH_MASK 0x1ff
#endif
__global__ void __launch_bounds__(NTHR, 2) fwd_kernel(Params p) {
    extern __shared__ __attribute__((aligned(16))) unsigned char lds_raw[];
    Frame F;
    F.lds = (LAS unsigned char*)lds_raw;
    F.wg = blockIdx.x; F.G = gridDim.x;
    F.ws = p.ws;

    volatile LAS unsigned* xbw = (volatile LAS unsigned*)(F.lds + MISC_OFF);
    if (threadIdx.x < 4) xbw[threadIdx.x] = 0u;
    __syncthreads();
    XcdBarrier bar; bar.bar = (unsigned*)(p.ws + WS_CTL); bar.x = 0; bar.st = xbw;
#if ONE_LAUNCH
    bar = xcd_barrier_post((unsigned*)(p.ws + WS_CTL), xbw);
#define GRID_BAR() xcd_barrier(bar)
#else
#define GRID_BAR() do { } while (0)
#endif
    const int lo = p.ph_lo, hi = p.ph_hi;
#define IN(k) (lo <= (k) && (k) < hi)
#define EN(b) ((PH_MASK >> (b)) & 1)
#define SEAM(k) do { if (IN((k) + 1)) GRID_BAR(); } while (0)

    if (EN(0) && IN(0)) { phase_prep(F, p); SEAM(0); }
    if (EN(1) && IN(1)) { phase_h0(F, p.in[0]); SEAM(1); }
    for (int l = 0; l < DEPTH; ++l) {
        const int pb = 2 + 7 * l;
        if (EN(2) && IN(pb + 0)) {
            unsigned char* ws = wsl(F);
            PolIn P; P.K = D; P.A = WSP(const char, ws, WS_H); P.B = (const char*)(WSP(bf16_t, ws, WS_WIN) + (size_t)l * ZLD * D); P.lista = nullptr; P.listw = nullptr; P.ord.init(T, ZLD, F.G, F.wg); P.Z = WSP(bf16_t, ws, WS_Z);
            gemm_phase<PolIn>(F.lds, P);
            SEAM(pb + 0);
        }
        if (EN(3) && IN(pb + 1)) { phase_mixer(F, l); SEAM(pb + 1); }
        if (EN(4) && IN(pb + 2)) {
            unsigned char* ws = wsl(F);
            PolOut P; P.K = D; P.A = WSP(const char, ws, WS_Y); P.B = (const char*)(WSP(bf16_t, ws, WS_WOUT) + (size_t)l * D * D); P.lista = nullptr; P.listw = nullptr; P.ord.init(T, D, F.G, F.wg);
            P.xres = WSP(float, ws, WS_X); P.xsrc = (l == 0) ? p.in[0] : P.xres; P.g1 = WSP(const float, ws, WS_ADA) + (size_t)l * NB * 6144 + 2048;
            gemm_phase<PolOut>(F.lds, P);
            SEAM(pb + 2);
        }
        if (EN(5) && IN(pb + 3)) { phase_ln1_router(F, l); SEAM(pb + 3); }
        if (EN(6) && IN(pb + 4)) {
            unsigned char* ws = wsl(F);
            const int NT = moe_sched(F, ws, l);
            PolMoe1 P; P.K = D; P.A = WSP(const char, ws, WS_H); P.B = (const char*)(WSP(bf16_t, ws, WS_WGU) + (size_t)l * NE * 1024 * 1024); P.lista = WSP(const int, ws, WS_LISTA); P.listw = WSP(const float, ws, WS_LISTW);
            P.ord.sched = (const LAS int*)(F.lds + SCHED_OFF); P.ord.NT = NT; P.ord.G = F.G; P.ord.c = F.wg; P.act = WSP(bf16_t, ws, WS_ACT);
            gemm_phase<PolMoe1>(F.lds, P);
            SEAM(pb + 4);
        }
        if (EN(7) && IN(pb + 5)) {
            unsigned char* ws = wsl(F);
            const int NT = moe_sched(F, ws, l);
            PolMoe2 P; P.K = DFF; P.A = WSP(const char, ws, WS_ACT); P.B = (const char*)(WSP(bf16_t, ws, WS_WDN) + (size_t)l * NE * 1024 * DFF); P.lista = WSP(const int, ws, WS_LISTA); P.listw = WSP(const float, ws, WS_LISTW);
            P.ord.sched = (const LAS int*)(F.lds + SCHED_OFF); P.ord.NT = NT; P.ord.G = F.G; P.ord.c = F.wg; P.ymoe = WSP(bf16_t, ws, WS_YMOE);
            gemm_phase<PolMoe2>(F.lds, P);
            SEAM(pb + 5);
        }
        if (EN(8) && IN(pb + 6)) { phase_ln2(F, l, p.out); if (l + 1 < DEPTH) SEAM(pb + 6); }
    }
#undef IN
#undef EN
#undef SEAM
}

extern "C" void kernel_launch(void* const* d_in, const int* in_sizes, int n_in, void* d_out, int out_size, void* d_ws, size_t ws_size, hipStream_t stream) {
    static int grid = 0;
    if (grid == 0) {
        if (n_in != 23 || out_size != T * D || ws_size < WS_END) { fprintf(stderr, "kernel_launch: unexpected shapes (n_in %d, out %d, ws %zu < %zu)\n", n_in, out_size, ws_size, (size_t)WS_END); grid = -1; return; }
        int dev = 0, cus = 0, per_cu = 0;
        if (hipGetDevice(&dev) != hipSuccess || hipDeviceGetAttribute(&cus, hipDeviceAttributeMultiprocessorCount, dev) != hipSuccess) { grid = -1; return; }
        if (hipFuncSetAttribute((const void*)fwd_kernel, hipFuncAttributeMaxDynamicSharedMemorySize, LDS_BYTES) != hipSuccess) { fprintf(stderr, "kernel_launch: hipFuncSetAttribute failed\n"); grid = -1; return; }
        if (hipOccupancyMaxActiveBlocksPerMultiprocessor(&per_cu, (const void*)fwd_kernel, NTHR, LDS_BYTES) != hipSuccess || per_cu < 1) { fprintf(stderr, "kernel_launch: occupancy query says %d\n", per_cu); (void)hipGetLastError(); per_cu = 1; }
        grid = cus;
        if (grid > 256) grid = 256;
    }
    if (grid < 0) return;
    (void)hipMemsetAsync((char*)d_ws + WS_CTL, 0, CTL_BYTES, stream);
    Params p{};
    for (int i = 0; i < 23; ++i) p.in[i] = (const float*)d_in[i];
    p.out = (float*)d_out; p.ws = (unsigned char*)d_ws;
#if ONE_LAUNCH
    p.ph_lo = 0; p.ph_hi = N_PHASES;
    hipLaunchKernelGGL(fwd_kernel, dim3(grid), dim3(NTHR), LDS_BYTES, stream, p);
#else
    for (int k = 0; k < N_PHASES; ++k) { p.ph_lo = k; p.ph_hi = k + 1; hipLaunchKernelGGL(fwd_kernel, dim3(grid), dim3(NTHR), LDS_BYTES, stream, p); }
#endif
}
```

```cpp
#include <hip/hip_runtime.h>
#include <cstdio>
#include <cstdint>

#ifndef ONE_LAUNCH
#define ONE_LAUNCH 1
#endif
#ifndef REP_MASK
#define REP_MASK 0
#endif

#define LAS __attribute__((address_space(3)))
typedef unsigned short bf16_t;
typedef short bf16x8 __attribute__((ext_vector_type(8)));
typedef unsigned short u16x4 __attribute__((ext_vector_type(4)));
typedef float f32x4 __attribute__((ext_vector_type(4)));
typedef float f32x2 __attribute__((ext_vector_type(2)));
typedef unsigned u32x4 __attribute__((ext_vector_type(4)));
typedef unsigned u32x2 __attribute__((ext_vector_type(2)));

constexpr int D = 1024, NB = 8, SEQ = 2048, T = NB * SEQ, DEPTH = 4;
constexpr int CONV_W = 384, POOL_W = 256, SGU_W = 384, D_IN = 2176, ZLD = 2304, CHUNK = 128;
constexpr int NE = 32, DFF = 512, LCAP = 16384;
constexpr int OFF_GB = 0, OFF_GC = 384, OFF_XC = 768, OFF_P = 1152, OFF_U = 1408, OFF_V = 1792;
constexpr float ALPHA = 1.681792830507429f, LN_EPS = 1e-5f;
constexpr int NTHR = 512;

constexpr size_t al256(size_t x) { return (x + 255) & ~(size_t)255; }
constexpr size_t WS_CTL = 0;
constexpr size_t CTL_BYTES = 65536;
constexpr size_t CTL_CNT = 16384;
constexpr size_t CTL_QHEAD = 49152;
constexpr size_t WS_ADA = WS_CTL + CTL_BYTES;
constexpr size_t WS_WRT = WS_ADA + al256((size_t)DEPTH * NB * 6144 * 4);
constexpr size_t WS_SGUW = WS_WRT + al256((size_t)NE * D * 4);
constexpr size_t WS_POOLW = WS_SGUW + al256((size_t)DEPTH * 6 * 128 * 128 * 2);
constexpr size_t WS_WIN = WS_POOLW + al256((size_t)DEPTH * 4 * 64 * 64 * 2);
constexpr size_t WS_WOUT = WS_WIN + al256((size_t)DEPTH * ZLD * D * 2);
constexpr size_t WS_WGU = WS_WOUT + al256((size_t)DEPTH * D * D * 2);
constexpr size_t WS_WDN = WS_WGU + al256((size_t)DEPTH * NE * 1024 * 1024 * 2);
constexpr size_t WS_X = WS_WDN + al256((size_t)DEPTH * NE * 1024 * 512 * 2);
constexpr size_t WS_H = WS_X + al256((size_t)T * D * 4);
constexpr size_t WS_Z = WS_H + al256((size_t)T * D * 2);
constexpr size_t WS_Y = WS_Z + al256((size_t)T * ZLD * 2);
constexpr size_t WS_ACT = WS_Y + al256((size_t)T * D * 2);
constexpr size_t WS_YMOE = WS_ACT + al256((size_t)(2 * T + NE * 256) * DFF * 2);
constexpr size_t WS_LISTA = WS_YMOE + al256((size_t)2 * T * D * 2);
constexpr size_t WS_LISTW = WS_LISTA + al256((size_t)NE * LCAP * 4);
constexpr size_t WS_SMALL = WS_LISTW + al256((size_t)NE * LCAP * 4);
constexpr size_t WS_X2 = WS_SMALL + al256((size_t)29728 * 4);
constexpr size_t WS_END = WS_X2 + al256((size_t)T * D * 4);
constexpr int SM_CONVW = 0, SM_CONVB = 4608, SM_PSCALE = 6144, SM_LNG = 7168, SM_LNB = 8704, SM_SGUB = 10240, SM_LN1G = 13312, SM_LN1B = 17408, SM_LN2G = 21504, SM_LN2B = 25600, SM_BR = 29696;

constexpr int LDS_BYTES = 147456;
constexpr int TAB_OFF = 131072;
constexpr int SCHED_OFF = TAB_OFF + 6144;
constexpr int MISC_OFF = SCHED_OFF + 2048;

#define XB_TMO      128
#define XB_XCNT(j)  (256  + 64 * (j))
#define XB_XSUB(j)  (1280 + 64 * (j))
#define XB_XGEN(j)  (2304 + 64 * (j))
#define XB_TOP      3328
#define XB_TOPGEN   3392
#define XCD_BAR_WORDS 3456
#define XB_SPIN_CAP (1u << 18)

__device__ __forceinline__ unsigned xb_ld(unsigned* p)              { return __hip_atomic_load(p, __ATOMIC_RELAXED, __HIP_MEMORY_SCOPE_AGENT); }
__device__ __forceinline__ unsigned xb_add(unsigned* p, unsigned v) { return __hip_atomic_fetch_add(p, v, __ATOMIC_RELAXED, __HIP_MEMORY_SCOPE_AGENT); }
__device__ __forceinline__ unsigned xb_xcc_id() { return (unsigned)__builtin_amdgcn_s_getreg((3 << 11) | 20) & 0xFu; }
#define XB_SPIN(cond, bar) do { unsigned _sp = 0; while (cond) { __builtin_amdgcn_s_sleep(1); \
    if ((++_sp & 255u) == 0u) { if (xb_ld(&(bar)[XB_TMO])) break; if (_sp > XB_SPIN_CAP) { atomicAdd(&(bar)[XB_TMO], 1u); break; } } } } while (0)

struct XcdBarrier {
    unsigned* bar; unsigned x;
    volatile LAS unsigned* st;
};

__device__ __forceinline__ XcdBarrier xcd_barrier_post(unsigned* bar, volatile LAS unsigned* st) {
    XcdBarrier b; b.bar = bar; b.x = xb_xcc_id(); b.st = st;
    if (threadIdx.x == 0) (void)xb_add(&bar[XB_XCNT(b.x)], 1u);
    return b;
}
__device__ __forceinline__ void xcd_barrier_complete(unsigned* bar, unsigned x, unsigned& nloc, unsigned& nx) {
    const unsigned G = gridDim.x * gridDim.y * gridDim.z;
    unsigned sum, cnt, mine, sp = 0u;
    for (;;) {
        sum = 0u; cnt = 0u; mine = 0u;
#pragma unroll
        for (unsigned j = 0; j < 16; ++j) { const unsigned c = xb_ld(&bar[XB_XCNT(j)]); sum += c; cnt += (c > 0u) ? 1u : 0u; mine = (j == x) ? c : mine; }
        if (sum == G) break;
        __builtin_amdgcn_s_sleep(1);
        if ((++sp & 255u) == 0u) { if (xb_ld(&bar[XB_TMO])) break; if (sp > XB_SPIN_CAP) { atomicAdd(&bar[XB_TMO], 1u); break; } }
    }
    nloc = mine > 0u ? mine : 1u; nx = cnt > 0u ? cnt : 1u;
}

__device__ __forceinline__ void xcd_barrier(const XcdBarrier& b) {
    asm volatile("s_waitcnt vmcnt(0)" ::: "memory");
    __syncthreads();
    if (threadIdx.x == 0) {
        unsigned* bar = b.bar;
        __builtin_amdgcn_s_waitcnt(0);
        unsigned nloc = b.st[0], nx = b.st[1];
        if (nloc == 0u) { xcd_barrier_complete(bar, b.x, nloc, nx); b.st[0] = nloc; b.st[1] = nx; }
        const unsigned old = xb_add(&bar[XB_XSUB(b.x)], 1u);
        const unsigned gen = old / nloc;
        if (old + 1u == (gen + 1u) * nloc) {
            __builtin_amdgcn_fence(__ATOMIC_RELEASE, "agent");
            asm volatile("s_waitcnt vmcnt(0)" ::: "memory");
            const unsigned og = xb_add(&bar[XB_TOP], 1u);
            const unsigned tg = og / nx;
            if (og + 1u == (tg + 1u) * nx) xb_add(&bar[XB_TOPGEN], 1u);
            else XB_SPIN(xb_ld(&bar[XB_TOPGEN]) == tg, bar);
            __builtin_amdgcn_fence(__ATOMIC_ACQUIRE, "agent");
            xb_add(&bar[XB_XGEN(b.x)], 1u);
            asm volatile("s_waitcnt vmcnt(0)" ::: "memory");
        } else {
            XB_SPIN(xb_ld(&bar[XB_XGEN(b.x)]) == gen, bar);
            __builtin_amdgcn_fence(__ATOMIC_ACQUIRE, "agent");
            asm volatile("s_waitcnt vmcnt(0)" ::: "memory");
        }
    }
    __syncthreads();
}

__device__ __forceinline__ int tid_l() { int t = threadIdx.x; asm volatile("" : "+v"(t)); return t; }
__device__ __forceinline__ unsigned cvt_pk_bf16(float lo, float hi) { unsigned r; asm("v_cvt_pk_bf16_f32 %0, %1, %2" : "=v"(r) : "v"(lo), "v"(hi)); return r; }
__device__ __forceinline__ float bf_lo(unsigned u) { return __uint_as_float(u << 16); }
__device__ __forceinline__ float bf_hi(unsigned u) { return __uint_as_float(u & 0xffff0000u); }
__device__ __forceinline__ void unpack8(const u32x4 v, float (&f)[8]) {
    f[0] = bf_lo(v.x); f[1] = bf_hi(v.x); f[2] = bf_lo(v.y); f[3] = bf_hi(v.y); f[4] = bf_lo(v.z); f[5] = bf_hi(v.z); f[6] = bf_lo(v.w); f[7] = bf_hi(v.w);
}
__device__ __forceinline__ u32x4 pack8(const float (&f)[8]) { u32x4 w; w.x = cvt_pk_bf16(f[0], f[1]); w.y = cvt_pk_bf16(f[2], f[3]); w.z = cvt_pk_bf16(f[4], f[5]); w.w = cvt_pk_bf16(f[6], f[7]); return w; }
__device__ __forceinline__ void st_wt16(void* p, u32x4 v) { asm volatile("global_store_dwordx4 %0, %1, off sc1\n\ts_nop 1" :: "v"(p), "v"(v) : "memory"); }
__device__ __forceinline__ void st_wt16f(void* p, f32x4 v) { asm volatile("global_store_dwordx4 %0, %1, off sc1\n\ts_nop 1" :: "v"(p), "v"(v) : "memory"); }
__device__ __forceinline__ void st_wt8(void* p, u32x2 v) { asm volatile("global_store_dwordx2 %0, %1, off sc1\n\ts_nop 1" :: "v"(p), "v"(v) : "memory"); }
__device__ __forceinline__ float silu_f(float g) { return g * __builtin_amdgcn_rcpf(1.0f + __expf(-g)); }
__device__ __forceinline__ float wave_sum(float s) {
#pragma unroll
    for (int o = 32; o; o >>= 1) s += __shfl_xor(s, o);
    return s;
}

constexpr int BM = 256, BK = 64, HALF = 128, HTB = HALF * BK * 2, NXCD = 8, WGM = 8;
__host__ __device__ __forceinline__ int lds_byte(int r, int c) { const int st = (r >> 4) * 2 + (c >> 5), rr = r & 15, cc = c & 31, ob = rr * 64 + cc * 2; return st * 1024 + (ob ^ (((ob >> 9) & 1) << 5)); }
__host__ __device__ __forceinline__ void stage_rc(int b, int& R, int& C) { const int st = b / 1024, sb = b % 1024, swz = sb ^ (((sb >> 9) & 1) << 5); R = (st >> 1) * 16 + swz / 64; C = (st & 1) * 32 + (swz % 64) / 2; }
__host__ __device__ __forceinline__ int perm32(int rho) { const int n = rho >> 4, i = rho & 15; return 8 * (i >> 2) + 4 * n + (i & 3); }

struct Unit { int arow, brow, orow, pn, nvalid, tsrc; };

struct DenseOrder {
    int nM, nN, nwg, G, c;
    __device__ void init(int M, int N, int G_, int c_) { nM = M / BM; nN = N / BM; nwg = nM * nN; G = G_; c = c_; }
    __device__ bool next(int i, Unit& u) const {
        const long L = (long)i * G + c; if (L >= nwg) return false;
        int wgid = (int)L; { const int q = nwg / NXCD, r = nwg % NXCD, xcd = wgid % NXCD, off = wgid / NXCD; wgid = (xcd < r ? xcd * (q + 1) : r * (q + 1) + (xcd - r) * q) + off; }
        const int nig = WGM * nN, gid = wgid / nig, fm = gid * WGM, gsz = (nM - fm) < WGM ? (nM - fm) : WGM;
        const int pm = fm + ((wgid % nig) % gsz), pn = (wgid % nig) / gsz;
        u.arow = pm * BM; u.brow = pn * BM; u.orow = pm * BM; u.pn = pn; u.nvalid = 256; u.tsrc = 0; return true;
    }
};
struct MoeOrder {
    const LAS int* sched; int NT, G, c;
    __device__ bool next(int i, Unit& u) const {
        const int uu = i * G + c, tl = uu >> 2; if (tl >= NT) return false;
        const int pn = uu & 3, e = __builtin_amdgcn_readfirstlane(sched[96 + tl]), r0 = (tl - __builtin_amdgcn_readfirstlane(sched[32 + e])) * 256, rem = __builtin_amdgcn_readfirstlane(sched[e]) - r0;
        u.arow = tl * 256; u.brow = e * 1024 + pn * 256; u.orow = tl * 256; u.pn = pn; u.nvalid = rem < 256 ? rem : 256; u.tsrc = e * LCAP + r0; return true;
    }
};

template <class P>
__device__ __forceinline__ void gemm_phase(LAS unsigned char* lds, const P& S) {
    constexpr int MODE = P::MODE;
    const int tid = tid_l(), wid = __builtin_amdgcn_readfirstlane(tid >> 6), lane = tid & 63, wr = wid >> 2, wc = wid & 3, fr = lane & 15, fq = lane >> 4;
    const int K = S.K, nt = K / BK;
    unsigned voffA[2], voffB[2];
#pragma unroll
    for (int i = 0; i < 2; ++i) { int R, C; stage_rc(tid * 16 + i * 8192, R, C); const int Rb = P::PERM ? ((R & ~31) + perm32(R & 31)) : R;
        voffA[i] = (unsigned)(R * K + C) * 2u; voffB[i] = (unsigned)(Rb * K + C) * 2u; }
    const size_t kstep = (size_t)(BK * 2);
    const size_t hstep = (size_t)HALF * K * 2;
    const unsigned ldsw = (unsigned)wid * 1024u;
    const int aoff = lds_byte(wr * 64 + fr, fq * 8), boff = lds_byte(wc * 32 + fr, fq * 8);
    LAS int* tabA = (LAS int*)(lds + TAB_OFF); LAS float* tabW = (LAS float*)(lds + TAB_OFF + 3072);
#define G_SA(b, h) (((b) * 2 + (h)) * HTB)
#define G_SB(b, h) ((4 + (b) * 2 + (h)) * HTB)
#define G_STAGE(bufoff, gbase, voff) do { _Pragma("unroll") for (int _i = 0; _i < 2; ++_i) \
        __builtin_amdgcn_global_load_lds((const unsigned*)((const char*)(gbase) + (voff)[_i]), (LAS unsigned*)(lds + (bufoff) + ldsw + _i * 8192), 16, 0, 0); } while (0)
#define G_STAGE_A(bufoff, dptr, h, kb) do { if constexpr (MODE == 1) { _Pragma("unroll") for (int _i = 0; _i < 2; ++_i) \
        __builtin_amdgcn_global_load_lds((const unsigned*)(S.A + (size_t)gofs[h][_i] + (kb)), (LAS unsigned*)(lds + (bufoff) + ldsw + _i * 8192), 16, 0, 0); } \
        else { G_STAGE(bufoff, (dptr) + (size_t)(h) * hstep + (kb), voffA); } } while (0)
#define G_GOFS(sl) do { int _tz = threadIdx.x; asm volatile("" : "+v"(_tz)); _Pragma("unroll") for (int _i = 0; _i < 2; ++_i) { int _R, _C; stage_rc(_tz * 16 + _i * 8192, _R, _C); \
        _Pragma("unroll") for (int _h = 0; _h < 2; ++_h) gofs[_h][_i] = (unsigned)(tabA[(sl) * 256 + _h * 128 + _R] >> 1) * (unsigned)(K * 2) + (unsigned)(_C * 2); } } while (0)
#define G_LDA(dst, b, h) do { _Pragma("unroll") for (int m = 0; m < 4; ++m) _Pragma("unroll") for (int k = 0; k < 2; ++k) dst[m][k] = *(const LAS bf16x8*)(lds + G_SA(b, h) + aoff + m * 2048 + k * 1024); } while (0)
#define G_LDB(dst, b, h) do { _Pragma("unroll") for (int n = 0; n < 2; ++n) _Pragma("unroll") for (int k = 0; k < 2; ++k) dst[n][k] = *(const LAS bf16x8*)(lds + G_SB(b, h) + boff + n * 2048 + k * 1024); } while (0)
#define G_MMA(ai, bj, At, Bt) do { __builtin_amdgcn_s_setprio(1); _Pragma("unroll") for (int m = 0; m < 4; ++m) _Pragma("unroll") for (int n = 0; n < 2; ++n) _Pragma("unroll") for (int k = 0; k < 2; ++k) \
        acc[ai][bj][m][n] = __builtin_amdgcn_mfma_f32_16x16x32_bf16(Bt[n][k], At[m][k], acc[ai][bj][m][n], 0, 0, 0); __builtin_amdgcn_s_setprio(0); } while (0)
#define G_WAIT_V(n) asm volatile("s_waitcnt vmcnt(" #n ")" ::: "memory")
#define G_WAIT_L(n) asm volatile("s_waitcnt lgkmcnt(" #n ")" ::: "memory")
#define G_BAR __builtin_amdgcn_s_barrier()
#define G_SCHED __builtin_amdgcn_sched_barrier(0)
    Unit cur, nxt; int ui = 0;
    if (!S.next(0, cur)) return;
    f32x4 acc[2][2][4][2];
#pragma unroll
    for (int a = 0; a < 2; ++a)
#pragma unroll
        for (int b = 0; b < 2; ++b)
#pragma unroll
            for (int m = 0; m < 4; ++m)
#pragma unroll
                for (int n = 0; n < 2; ++n) acc[a][b][m][n] = (f32x4){0.f, 0.f, 0.f, 0.f};
    bf16x8 At[4][2], B0[2][2], B1[2][2];
    unsigned gofs[2][2] = {{0u, 0u}, {0u, 0u}};
    if constexpr (MODE != 0) {
        if (tid < 256) { const int rl = cur.nvalid - 1; const int idx = cur.tsrc + (tid < rl ? tid : rl);
            tabA[tid] = S.lista[idx]; if constexpr (MODE == 1) tabW[tid] = S.listw[idx]; }
        __syncthreads();
        if constexpr (MODE == 1) G_GOFS(0);
    }
    const char* cA = S.A + (size_t)cur.arow * K * 2; const char* cB = S.B + (size_t)cur.brow * K * 2;
    G_STAGE(G_SB(0, 0), cB, voffB); G_STAGE_A(G_SA(0, 0), cA, 0, 0); G_STAGE(G_SB(0, 1), cB + hstep, voffB); G_STAGE_A(G_SA(0, 1), cA, 1, 0);
    if (wr == 1) G_BAR;
    G_WAIT_V(4); G_BAR;
    G_STAGE(G_SB(1, 0), cB + kstep, voffB); G_STAGE_A(G_SA(1, 0), cA, 0, kstep); G_STAGE(G_SB(1, 1), cB + hstep + kstep, voffB);
    G_WAIT_V(6); G_BAR;
    for (;;) {
        const bool has_next = S.next(ui + 1, nxt);
        const char* nA = has_next ? S.A + (size_t)nxt.arow * K * 2 : cA; const char* nB = has_next ? S.B + (size_t)nxt.brow * K * 2 : cB;
        const int slot_n = (ui + 1) % 3;
        if constexpr (MODE != 0) {
            if (has_next && wid < 4) {
                const int rr = tid_l(), rl = nxt.nvalid - 1; const int idx = nxt.tsrc + (rr < rl ? rr : rl);
                __builtin_amdgcn_global_load_lds((const unsigned*)(S.lista + idx), (LAS unsigned*)(tabA + slot_n * 256 + wid * 64), 4, 0, 0);
                if constexpr (MODE == 1) __builtin_amdgcn_global_load_lds((const unsigned*)(S.listw + idx), (LAS unsigned*)(tabW + slot_n * 256 + wid * 64), 4, 0, 0);
            }
        }
        for (int t = 0; t < nt; t += 2) {
            const bool last = (t == nt - 2);
            const size_t k1 = (size_t)(t + 1) * kstep;
            const size_t k2 = last ? 0 : (size_t)(t + 2) * kstep, k3 = k2 + kstep;
            const char* a2p = last ? nA : cA; const char* b2 = (last ? nB : cB) + k2; const char* b3 = b2 + kstep;
            G_LDB(B0, 0, 0); G_SCHED; G_LDA(At, 0, 0); G_STAGE_A(G_SA(1, 1), cA, 1, k1);
            G_WAIT_L(8); G_BAR; G_WAIT_L(0); G_MMA(0, 0, At, B0); G_BAR; G_SCHED;
            if constexpr (MODE == 1) { if (last && has_next) G_GOFS(slot_n); }
            G_LDB(B1, 0, 1); G_STAGE(G_SB(0, 0), b2, voffB);
            G_BAR; G_WAIT_L(0); G_MMA(0, 1, At, B1); G_BAR;
            G_LDA(At, 0, 1); G_STAGE_A(G_SA(0, 0), a2p, 0, k2);
            G_BAR; G_WAIT_L(0); G_MMA(1, 0, At, B0); G_BAR; G_SCHED;
            G_STAGE(G_SB(0, 1), b2 + hstep, voffB);
            G_WAIT_V(6); G_BAR; G_MMA(1, 1, At, B1); G_BAR;
            G_LDB(B0, 1, 0); G_SCHED; G_LDA(At, 1, 0); G_STAGE_A(G_SA(0, 1), a2p, 1, k2);
            G_WAIT_L(8); G_BAR; G_WAIT_L(0); G_MMA(0, 0, At, B0); G_BAR; G_SCHED;
            G_LDB(B1, 1, 1); G_STAGE(G_SB(1, 0), b3, voffB);
            G_BAR; G_WAIT_L(0); G_MMA(0, 1, At, B1); G_BAR;
            G_LDA(At, 1, 1); G_STAGE_A(G_SA(1, 0), a2p, 0, k3);
            G_BAR; G_WAIT_L(0); G_MMA(1, 0, At, B0); G_BAR; G_SCHED;
            G_STAGE(G_SB(1, 1), b3 + hstep, voffB);
            G_WAIT_V(6); G_BAR; G_MMA(1, 1, At, B1); G_BAR;
        }
        S.epi(acc, cur, tabA + (ui % 3) * 256, tabW + (ui % 3) * 256);
        if (!has_next) break;
#pragma unroll
        for (int a = 0; a < 2; ++a)
#pragma unroll
            for (int b = 0; b < 2; ++b)
#pragma unroll
                for (int m = 0; m < 4; ++m)
#pragma unroll
                    for (int n = 0; n < 2; ++n) acc[a][b][m][n] = (f32x4){0.f, 0.f, 0.f, 0.f};
        cur = nxt; cA = nA; cB = nB; ++ui;
    }
    G_WAIT_V(0);
    if (wr == 0) G_BAR;
    G_BAR;
#undef G_SA
#undef G_SB
#undef G_STAGE
#undef G_STAGE_A
#undef G_GOFS
#undef G_LDA
#undef G_LDB
#undef G_MMA
#undef G_WAIT_V
#undef G_WAIT_L
#undef G_BAR
#undef G_SCHED
}

struct PolIn {
    static constexpr int MODE = 0; static constexpr bool PERM = true;
    int K; const char* A; const char* B; const int* lista; const float* listw; DenseOrder ord; bf16_t* Z;
    __device__ bool next(int i, Unit& u) const { return ord.next(i, u); }
    __device__ __forceinline__ void epi(const f32x4 (&acc)[2][2][4][2], const Unit& u, const LAS int*, const LAS float*) const {
        const int tz = tid_l(), wid = tz >> 6, lane = tz & 63, wr = wid >> 2, wc = wid & 3, fr = lane & 15, fq = lane >> 4;
        const int row0 = u.orow + wr * 64 + fr, col0 = u.pn * BM + wc * 32 + 8 * fq;
#pragma unroll
        for (int ai = 0; ai < 2; ++ai)
#pragma unroll
            for (int m = 0; m < 4; ++m) { bf16_t* rowp = Z + (size_t)(row0 + ai * HALF + m * 16) * ZLD + col0;
#pragma unroll
                for (int bj = 0; bj < 2; ++bj) { const f32x4 v0 = acc[ai][bj][m][0], v1 = acc[ai][bj][m][1];
                    u32x4 w; w.x = cvt_pk_bf16(v0[0], v0[1]); w.y = cvt_pk_bf16(v0[2], v0[3]); w.z = cvt_pk_bf16(v1[0], v1[1]); w.w = cvt_pk_bf16(v1[2], v1[3]);
                    *(u32x4*)(rowp + bj * HALF) = w; } }
    }
};
struct PolOut {
    static constexpr int MODE = 0; static constexpr bool PERM = true;
    int K; const char* A; const char* B; const int* lista; const float* listw; DenseOrder ord; bf16_t* xres; const float* g1;
    __device__ bool next(int i, Unit& u) const { return ord.next(i, u); }
    __device__ __forceinline__ void epi(const f32x4 (&acc)[2][2][4][2], const Unit& u, const LAS int*, const LAS float*) const {
        const int tz = tid_l(), wid = tz >> 6, lane = tz & 63, wr = wid >> 2, wc = wid & 3, fr = lane & 15, fq = lane >> 4;
        const int row0 = u.orow + wr * 64 + fr, col0 = u.pn * BM + wc * 32 + 8 * fq;
        const float* gp = g1 + (size_t)(u.orow / SEQ) * 6144 + col0;
        f32x4 gv[2][2];
#pragma unroll
        for (int bj = 0; bj < 2; ++bj)
#pragma unroll
            for (int n = 0; n < 2; ++n) gv[bj][n] = *(const f32x4*)(gp + bj * HALF + n * 4);
#pragma unroll
        for (int ai = 0; ai < 2; ++ai)
#pragma unroll
            for (int m = 0; m < 4; ++m) { bf16_t* rp = xres + (size_t)(row0 + ai * HALF + m * 16) * D + col0;
                u32x4 raw[2];
#pragma unroll
                for (int bj = 0; bj < 2; ++bj) raw[bj] = *(const u32x4*)(rp + bj * HALF);
#pragma unroll
                for (int bj = 0; bj < 2; ++bj) { float xs[8], o[8]; unpack8(raw[bj], xs);
#pragma unroll
                    for (int n = 0; n < 2; ++n)
#pragma unroll
                        for (int j = 0; j < 4; ++j) o[n * 4 + j] = xs[n * 4 + j] * ALPHA + gv[bj][n][j] * acc[ai][bj][m][n][j];
                    *(u32x4*)(rp + bj * HALF) = pack8(o); }
                if (m & 1) asm volatile("" ::: "memory"); }
    }
};
struct PolMoe1 {
    static constexpr int MODE = 1; static constexpr bool PERM = true;
    int K; const char* A; const char* B; const int* lista; const float* listw; MoeOrder ord; bf16_t* act;
    __device__ bool next(int i, Unit& u) const { return ord.next(i, u); }
    __device__ __forceinline__ void epi(const f32x4 (&acc)[2][2][4][2], const Unit& u, const LAS int*, const LAS float* tW) const {
        const int tz = tid_l(), wid = tz >> 6, lane = tz & 63, wr = wid >> 2, wc = wid & 3, fr = lane & 15, fq = lane >> 4;
        const int col0 = u.pn * HALF + wc * 32 + 8 * fq;
#pragma unroll
        for (int ai = 0; ai < 2; ++ai)
#pragma unroll
            for (int m = 0; m < 4; ++m) { const int rl = ai * HALF + wr * 64 + m * 16 + fr; const float w = tW[rl];
                float o[8];
#pragma unroll
                for (int n = 0; n < 2; ++n)
#pragma unroll
                    for (int j = 0; j < 4; ++j) o[n * 4 + j] = silu_f(acc[ai][0][m][n][j]) * acc[ai][1][m][n][j] * w;
                *(u32x4*)(act + (size_t)(u.orow + rl) * DFF + col0) = pack8(o); }
    }
};
struct PolMoe2 {
    static constexpr int MODE = 2; static constexpr bool PERM = true;
    int K; const char* A; const char* B; const int* lista; const float* listw; MoeOrder ord; bf16_t* ymoe;
    __device__ bool next(int i, Unit& u) const { return ord.next(i, u); }
    __device__ __forceinline__ void epi(const f32x4 (&acc)[2][2][4][2], const Unit& u, const LAS int* tA, const LAS float*) const {
        const int tz = tid_l(), wid = tz >> 6, lane = tz & 63, wr = wid >> 2, wc = wid & 3, fr = lane & 15, fq = lane >> 4;
        const int col0 = u.pn * BM + wc * 32 + 8 * fq;
#pragma unroll
        for (int ai = 0; ai < 2; ++ai)
#pragma unroll
            for (int m = 0; m < 4; ++m) { const int rl = ai * HALF + wr * 64 + m * 16 + fr; const int a = tA[rl];
                if (rl < u.nvalid) { bf16_t* rowp = ymoe + (size_t)a * D + col0;
#pragma unroll
                    for (int bj = 0; bj < 2; ++bj) { const f32x4 v0 = acc[ai][bj][m][0], v1 = acc[ai][bj][m][1];
                        u32x4 w; w.x = cvt_pk_bf16(v0[0], v0[1]); w.y = cvt_pk_bf16(v0[2], v0[3]); w.z = cvt_pk_bf16(v1[0], v1[1]); w.w = cvt_pk_bf16(v1[2], v1[3]);
                        *(u32x4*)(rowp + bj * HALF) = w; } } }
    }
};

struct Params { const float* in[23]; float* out; unsigned char* ws; int ph_lo, ph_hi; };
struct Frame { LAS unsigned char* lds; int wg, G; unsigned char* ws; };
__device__ __forceinline__ unsigned char* wsl(const Frame& F) { unsigned char* w = F.ws; asm volatile("" : "+s"(w)); return w; }
#define WSP(T, w, off) ((T*)((w) + (off)))

struct PrepPtrs { const float *w_in, *w_out, *w_gate, *w_up, *w_down; bf16_t *win, *wout, *wgu, *wdn; };
constexpr int PT_IN = DEPTH * 34 * 16, PT_OUT = DEPTH * 16 * 16, PT_G = DEPTH * NE * 8 * 16, PT_D = DEPTH * NE * 16 * 8;
constexpr int PREP_WTASKS = PT_IN + PT_OUT + 2 * PT_G + PT_D;
__device__ __forceinline__ void prep_decode(int task, const PrepPtrs& Q, const float*& src, bf16_t*& dst, int& N, int& Kd, int& n0, int& k0, int& mode) {
    if (task < PT_IN) { const int l = task / 544, r = task % 544; src = Q.w_in + (size_t)l * D * D_IN; dst = Q.win + (size_t)l * ZLD * D; N = D_IN; Kd = D; n0 = (r >> 4) * 64; k0 = (r & 15) * 64; mode = 0; return; }
    task -= PT_IN;
    if (task < PT_OUT) { const int l = task >> 8, r = task & 255; src = Q.w_out + (size_t)l * D * D; dst = Q.wout + (size_t)l * D * D; N = D; Kd = D; n0 = (r >> 4) * 64; k0 = (r & 15) * 64; mode = 0; return; }
    task -= PT_OUT;
    if (task < PT_G) { const int mat = task >> 7, r = task & 127; src = Q.w_gate + (size_t)mat * D * DFF; dst = Q.wgu + (size_t)mat * 1024 * 1024; N = DFF; Kd = D; n0 = (r >> 4) * 64; k0 = (r & 15) * 64; mode = 1; return; }
    task -= PT_G;
    if (task < PT_G) { const int mat = task >> 7, r = task & 127; src = Q.w_up + (size_t)mat * D * DFF; dst = Q.wgu + (size_t)mat * 1024 * 1024; N = DFF; Kd = D; n0 = (r >> 4) * 64; k0 = (r & 15) * 64; mode = 2; return; }
    task -= PT_G;
    { const int mat = task >> 7, r = task & 127; src = Q.w_down + (size_t)mat * DFF * D; dst = Q.wdn + (size_t)mat * 1024 * DFF; N = D; Kd = DFF; n0 = (r >> 3) * 64; k0 = (r & 7) * 64; mode = 0; }
}
__device__ __forceinline__ void prep_task(int task, const PrepPtrs& Q, int lane) {
    const float* src; bf16_t* dst; int N, Kd, n0, k0, mode; prep_decode(task, Q, src, dst, N, Kd, n0, k0, mode);
    const int f = n0 + lane;
    const float* p = src + (size_t)k0 * N + f;
    float v[64];
#pragma unroll
    for (int q = 0; q < 64; ++q) v[q] = p[(size_t)q * N];
    const int row = mode == 0 ? f : ((f >> 7) * 256 + (f & 127) + (mode == 2 ? 128 : 0));
    bf16_t* d = dst + (size_t)row * Kd + k0;
#pragma unroll
    for (int q = 0; q < 8; ++q) { u32x4 w; w.x = cvt_pk_bf16(v[8 * q], v[8 * q + 1]); w.y = cvt_pk_bf16(v[8 * q + 2], v[8 * q + 3]); w.z = cvt_pk_bf16(v[8 * q + 4], v[8 * q + 5]); w.w = cvt_pk_bf16(v[8 * q + 6], v[8 * q + 7]);
        *(u32x4*)(d + 8 * q) = w; }
}
__device__ __forceinline__ void copy_f32(float* dst, const float* src, int n, int gtid, int gn) { for (int i = gtid; i < n; i += gn) dst[i] = src[i]; }
__device__ __forceinline__ void phase_prep(const Frame& F, const Params& p) {
    const int tid = tid_l(), lane = tid & 63, wave = __builtin_amdgcn_readfirstlane(tid >> 6), wg = F.wg;
    unsigned char* ws = wsl(F);
    {
        const float* c_in = p.in[1]; const float* w_ada = p.in[2]; const float* b_ada = p.in[3]; float* ada = WSP(float, ws, WS_ADA);
        LAS float* cs = (LAS float*)F.lds;
        LAS float* part = (LAS float*)(F.lds + 32768);
        for (int i = tid; i < NB * D; i += NTHR) { const int b = i >> 10, k = i & 1023; const float v = c_in[i]; cs[k * 8 + b] = v / (1.f + __expf(-v)); }
        __syncthreads();
        const int l = wg >> 6, j0 = (wg & 63) * 96, ks = lane >> 5, cq = lane & 31;
        if (cq < 24) {
            f32x4 acc[8];
#pragma unroll
            for (int b = 0; b < 8; ++b) acc[b] = (f32x4){0.f, 0.f, 0.f, 0.f};
            const float* wp = w_ada + ((size_t)l * D + wave * 128 + ks) * 6144 + j0 + 4 * cq;
#pragma unroll 8
            for (int i = 0; i < 64; ++i) {
                const f32x4 w4 = *(const f32x4*)(wp + (size_t)(2 * i) * 6144);
                const int k = wave * 128 + 2 * i + ks;
                const f32x4 c0 = *(const LAS f32x4*)(cs + k * 8), c1 = *(const LAS f32x4*)(cs + k * 8 + 4);
                acc[0] += w4 * c0[0]; acc[1] += w4 * c0[1]; acc[2] += w4 * c0[2]; acc[3] += w4 * c0[3];
                acc[4] += w4 * c1[0]; acc[5] += w4 * c1[1]; acc[6] += w4 * c1[2]; acc[7] += w4 * c1[3];
            }
#pragma unroll
            for (int b = 0; b < 8; ++b) *(LAS f32x4*)(part + ((wave * 2 + ks) * 8 + b) * 96 + 4 * cq) = acc[b];
        }
        __syncthreads();
        for (int o = tid; o < 768; o += NTHR) { const int b = o / 96, j = o % 96; float s = 0.f;
#pragma unroll
            for (int q = 0; q < 16; ++q) s += part[(q * 8 + b) * 96 + j];
            ada[((size_t)l * NB + b) * 6144 + j0 + j] = s + b_ada[l * 6144 + j0 + j]; }
        __syncthreads();
    }
    const int gtid = wg * NTHR + tid, gn = F.G * NTHR;
    {
        const float* w_router = p.in[16]; float* wrt = WSP(float, ws, WS_WRT);
        for (int i = gtid; i < NE * D; i += gn) { const int e = i >> 10, k = i & 1023; wrt[i] = w_router[k * NE + e]; }
        const float* sgu_w = p.in[11]; bf16_t* sguw = WSP(bf16_t, ws, WS_SGUW);
        for (int i = gtid; i < DEPTH * 6 * 128 * 128; i += gn) { const int sx = i & 127, t = (i >> 7) & 127; sguw[i] = (bf16_t)(cvt_pk_bf16(sx <= t ? sgu_w[i] : 0.f, 0.f) & 0xffffu); }
        const float* pool_w = p.in[7]; bf16_t* poolw = WSP(bf16_t, ws, WS_POOLW);
        for (int i = gtid; i < DEPTH * 4 * 64 * 64; i += gn) { const int cc = i & 63, d = (i >> 6) & 63, lg = i >> 12; poolw[i] = (bf16_t)(cvt_pk_bf16(pool_w[(lg * 64 + cc) * 64 + d], 0.f) & 0xffffu); }
        bf16_t* win = WSP(bf16_t, ws, WS_WIN);
        for (int i = gtid; i < DEPTH * 128 * 128; i += gn) { const int l = i >> 14, r = i & 16383; *(u32x4*)(win + ((size_t)l * ZLD + D_IN) * D + (size_t)r * 8) = (u32x4){0u, 0u, 0u, 0u}; }
        float* sm = WSP(float, ws, WS_SMALL);
        copy_f32(sm + SM_CONVW, p.in[5], 4608, gtid, gn); copy_f32(sm + SM_CONVB, p.in[6], 1536, gtid, gn); copy_f32(sm + SM_PSCALE, p.in[8], 1024, gtid, gn);
        copy_f32(sm + SM_LNG, p.in[9], 1536, gtid, gn); copy_f32(sm + SM_LNB, p.in[10], 1536, gtid, gn); copy_f32(sm + SM_SGUB, p.in[12], 3072, gtid, gn);
        copy_f32(sm + SM_LN1G, p.in[14], 4096, gtid, gn); copy_f32(sm + SM_LN1B, p.in[15], 4096, gtid, gn); copy_f32(sm + SM_LN2G, p.in[21], 4096, gtid, gn); copy_f32(sm + SM_LN2B, p.in[22], 4096, gtid, gn);
        copy_f32(sm + SM_BR, p.in[17], 32, gtid, gn);
    }
    PrepPtrs Q; Q.w_in = p.in[4]; Q.w_out = p.in[13]; Q.w_gate = p.in[18]; Q.w_up = p.in[19]; Q.w_down = p.in[20];
    Q.win = WSP(bf16_t, ws, WS_WIN); Q.wout = WSP(bf16_t, ws, WS_WOUT); Q.wgu = WSP(bf16_t, ws, WS_WGU); Q.wdn = WSP(bf16_t, ws, WS_WDN);
    for (int t0 = wg * 8 + wave; t0 < PT_IN + PT_OUT + 3 * 4096; t0 += F.G * 8) {
        int gid = t0; if (t0 >= PT_IN + PT_OUT) { const int q = t0 - (PT_IN + PT_OUT); gid = PT_IN + PT_OUT + (q >> 12) * PT_G + (q & 4095); }
        prep_task(gid, Q, lane);
    }
}
constexpr int FILL_GRABS = 3 * 4096 / 8;
__device__ __forceinline__ void fill_prep(const Frame& F, const Params& p, int lay, int ngrab) {
    const int tid = tid_l(), lane = tid & 63, wave = __builtin_amdgcn_readfirstlane(tid >> 6);
    unsigned char* ws = wsl(F);
    const float* w_gate = p.in[18]; const float* w_up = p.in[19]; const float* w_down = p.in[20];
    bf16_t* wgu = WSP(bf16_t, ws, WS_WGU); bf16_t* wdn = WSP(bf16_t, ws, WS_WDN);
    unsigned* qh = WSP(unsigned, ws, WS_CTL + CTL_QHEAD) + lay * 64;
    LAS int* bc = (LAS int*)(F.lds + MISC_OFF + 1920);
    const bool on = lay >= 1 && lay < DEPTH;
    int left = on ? (ngrab < 0 ? FILL_GRABS : ngrab) : 0;
    while (left > 0) {
        __syncthreads();
        if (tid == 0) bc[0] = (int)__hip_atomic_fetch_add(qh, 1u, __ATOMIC_RELAXED, __HIP_MEMORY_SCOPE_AGENT);
        __syncthreads();
        const int t = __builtin_amdgcn_readfirstlane(bc[0]);
        if (t >= FILL_GRABS) { left = 0; continue; }
        --left;
        const int q = t * 8 + wave, r = q >> 12, within = q & 4095, mat = lay * 32 + (within >> 7), rr = within & 127;
        const bool dn = (r == 2);
        const float* src = dn ? w_down + (size_t)mat * DFF * D : (r == 0 ? w_gate : w_up) + (size_t)mat * D * DFF;
        bf16_t* dst = dn ? wdn + (size_t)mat * 1024 * DFF : wgu + (size_t)mat * 1024 * 1024;
        const int N = dn ? D : DFF, Kd = dn ? DFF : D, n0 = (dn ? (rr >> 3) : (rr >> 4)) * 64, k0 = (dn ? (rr & 7) : (rr & 15)) * 64;
        const int f = n0 + lane;
        const float* pp = src + (size_t)k0 * N + f;
        float v[64];
#pragma unroll
        for (int i = 0; i < 64; ++i) v[i] = pp[(size_t)i * N];
        const int row = dn ? f : ((f >> 7) * 256 + (f & 127) + (r == 1 ? 128 : 0));
        bf16_t* d = dst + (size_t)row * Kd + k0;
#pragma unroll
        for (int i = 0; i < 8; ++i) { u32x4 w; w.x = cvt_pk_bf16(v[8 * i], v[8 * i + 1]); w.y = cvt_pk_bf16(v[8 * i + 2], v[8 * i + 3]); w.z = cvt_pk_bf16(v[8 * i + 4], v[8 * i + 5]); w.w = cvt_pk_bf16(v[8 * i + 6], v[8 * i + 7]);
            *(u32x4*)(d + 8 * i) = w; }
    }
}
__device__ __forceinline__ void phase_h0(const Frame& F, const float* x) {
    unsigned char* ws = wsl(F);
    const float* ada = WSP(const float, ws, WS_ADA); bf16_t* hb = WSP(bf16_t, ws, WS_H); bf16_t* xb = WSP(bf16_t, ws, WS_X);
    const int gtid = F.wg * NTHR + tid_l(), gn = F.G * NTHR;
    for (int v = gtid; v < T * D / 8; v += gn) {
        const int tok = v >> 7, c = (v & 127) * 8, b = tok / SEQ;
        const float* xp = x + (size_t)tok * D + c; const float* ap = ada + (size_t)b * 6144 + c;
        const f32x4 x0 = *(const f32x4*)xp, x1 = *(const f32x4*)(xp + 4), sh0 = *(const f32x4*)ap, sh1 = *(const f32x4*)(ap + 4), sc0 = *(const f32x4*)(ap + 1024), sc1 = *(const f32x4*)(ap + 1028);
        const f32x4 h0 = x0 * (sc0 + 1.0f) + sh0, h1 = x1 * (sc1 + 1.0f) + sh1;
        u32x4 w; w.x = cvt_pk_bf16(h0[0], h0[1]); w.y = cvt_pk_bf16(h0[2], h0[3]); w.z = cvt_pk_bf16(h1[0], h1[1]); w.w = cvt_pk_bf16(h1[2], h1[3]);
        *(u32x4*)(hb + (size_t)tok * D + c) = w;
        u32x4 wx; wx.x = cvt_pk_bf16(x0[0], x0[1]); wx.y = cvt_pk_bf16(x0[2], x0[3]); wx.z = cvt_pk_bf16(x1[0], x1[1]); wx.w = cvt_pk_bf16(x1[2], x1[3]);
        *(u32x4*)(xb + (size_t)tok * D + c) = wx;
    }
}

__device__ __forceinline__ u16x4 tr_read(unsigned lds_addr) { u16x4 r; asm volatile("ds_read_b64_tr_b16 %0, %1\n\ts_waitcnt lgkmcnt(0)" : "=&v"(r) : "v"(lds_addr) : "memory"); return r; }

__device__ __forceinline__ void mixer_conv(const Frame& F, unsigned char* ws, int l, int tok0, int n) {
    const int tid = tid_l();
    const bf16_t* zb = WSP(const bf16_t, ws, WS_Z); bf16_t* yb = WSP(bf16_t, ws, WS_Y); const float* sm = WSP(const float, ws, WS_SMALL);
    if (tid < 480) {
        const int cv = tid % 48, tseg = tid / 48, tb = tseg * 13, te = (tb + 13) < 128 ? (tb + 13) : 128;
        const float* cw = sm + SM_CONVW + (size_t)l * 3 * CONV_W + cv * 8; const float* cb = sm + SM_CONVB + (size_t)l * CONV_W + cv * 8;
        float w0[8], w1[8], w2[8], bb[8];
#pragma unroll
        for (int j = 0; j < 8; ++j) { w0[j] = cw[j]; w1[j] = cw[CONV_W + j]; w2[j] = cw[2 * CONV_W + j]; bb[j] = cb[j]; }
        const bf16_t* zr = zb + (size_t)(tok0 + tb) * ZLD + cv * 8;
        const int pos = n * CHUNK + tb;
        float q1[8], q2[8];
#pragma unroll
        for (int j = 0; j < 8; ++j) { q1[j] = 0.f; q2[j] = 0.f; }
        if (pos >= 1) { float a[8], b[8]; unpack8(*(const u32x4*)(zr - ZLD + OFF_GC), a); unpack8(*(const u32x4*)(zr - ZLD + OFF_XC), b);
#pragma unroll
            for (int j = 0; j < 8; ++j) q1[j] = a[j] * b[j]; }
        if (pos >= 2) { float a[8], b[8]; unpack8(*(const u32x4*)(zr - 2 * ZLD + OFF_GC), a); unpack8(*(const u32x4*)(zr - 2 * ZLD + OFF_XC), b);
#pragma unroll
            for (int j = 0; j < 8; ++j) q2[j] = a[j] * b[j]; }
        for (int t = tb; t < te; ++t) {
            float g[8], a[8], b[8], o[8];
            unpack8(*(const u32x4*)(zr + OFF_GB), g); unpack8(*(const u32x4*)(zr + OFF_GC), a); unpack8(*(const u32x4*)(zr + OFF_XC), b);
#pragma unroll
            for (int j = 0; j < 8; ++j) { const float q0 = a[j] * b[j]; o[j] = g[j] * (w0[j] * q2[j] + w1[j] * q1[j] + w2[j] * q0 + bb[j]); q2[j] = q1[j]; q1[j] = q0; }
            *(u32x4*)(yb + (size_t)(tok0 + t) * D + cv * 8) = pack8(o);
            zr += ZLD;
        }
    }
}
constexpr int PL_LD = 264;
template <int WIN>
__device__ __forceinline__ void pool_rows(const bf16_t* pr, int pos0, LAS bf16_t* dstl) {
    constexpr int NR = WIN + 7;
    u32x4 raw[NR];
#pragma unroll
    for (int i = 0; i < NR; ++i) { const int rel = i - (WIN - 1); const bool ok = (pos0 + rel) >= 0; raw[i] = *(const u32x4*)(pr + (ptrdiff_t)(ok ? rel : 0) * ZLD); if (!ok) raw[i] = (u32x4){0u, 0u, 0u, 0u}; }
    float S[8];
#pragma unroll
    for (int j = 0; j < 8; ++j) S[j] = 0.f;
#pragma unroll
    for (int i = 0; i < WIN - 1; ++i) { float a[8]; unpack8(raw[i], a);
#pragma unroll
        for (int j = 0; j < 8; ++j) S[j] += a[j]; }
#pragma unroll
    for (int t = 0; t < 8; ++t) {
        const int pos = pos0 + t; float pv[8], o[8]; unpack8(raw[WIN - 1 + t], pv);
        const float inv = 1.0f / (float)((pos + 1) < WIN ? (pos + 1) : WIN);
#pragma unroll
        for (int j = 0; j < 8; ++j) { S[j] += pv[j]; o[j] = S[j] * inv - pv[j]; }
        *(LAS u32x4*)(dstl + t * PL_LD) = pack8(o);
        float a[8]; unpack8(raw[t], a);
#pragma unroll
        for (int j = 0; j < 8; ++j) S[j] -= a[j];
    }
}
__device__ __forceinline__ void mixer_pool(const Frame& F, unsigned char* ws, int l, int tok0, int n) {
    const int tid = tid_l(), lane = tid & 63, wave = __builtin_amdgcn_readfirstlane(tid >> 6);
    const bf16_t* zb = WSP(const bf16_t, ws, WS_Z); bf16_t* yb = WSP(bf16_t, ws, WS_Y); const float* sm = WSP(const float, ws, WS_SMALL);
    LAS bf16_t* PL = (LAS bf16_t*)F.lds;
    {
        const int g = wave & 3, seg = (lane >> 3) + 8 * (wave >> 2), cv = g * 8 + (lane & 7);
        const int pos0 = n * CHUNK + seg * 8;
        const bf16_t* pr = zb + (size_t)(tok0 + seg * 8) * ZLD + OFF_P + cv * 8;
        LAS bf16_t* dl = PL + (seg * 8) * PL_LD + cv * 8;
        if (g == 0) pool_rows<2>(pr, pos0, dl); else if (g == 1) pool_rows<4>(pr, pos0, dl); else if (g == 2) pool_rows<8>(pr, pos0, dl); else pool_rows<16>(pr, pos0, dl);
    }
    __syncthreads();
    {
        const int fr = lane & 15, fq = lane >> 4, t0 = wave * 16;
        const bf16_t* wt = WSP(const bf16_t, ws, WS_POOLW) + (size_t)l * 4 * 64 * 64;
        const float* sc = sm + SM_PSCALE + (size_t)l * POOL_W;
#pragma unroll
        for (int g = 0; g < 4; ++g) {
            bf16x8 yf[2], xf[4][2]; f32x4 s4[4];
#pragma unroll
            for (int db = 0; db < 4; ++db) { s4[db] = *(const f32x4*)(sc + g * 64 + db * 16 + 4 * fq);
#pragma unroll
                for (int ks = 0; ks < 2; ++ks) xf[db][ks] = *(const bf16x8*)(wt + ((size_t)(g * 64 + db * 16 + fr)) * 64 + ks * 32 + fq * 8); }
#pragma unroll
            for (int ks = 0; ks < 2; ++ks) yf[ks] = *(const LAS bf16x8*)(PL + (t0 + fr) * PL_LD + g * 64 + ks * 32 + fq * 8);
#pragma unroll
            for (int db = 0; db < 4; ++db) {
                f32x4 acc = (f32x4){0.f, 0.f, 0.f, 0.f};
#pragma unroll
                for (int ks = 0; ks < 2; ++ks) acc = __builtin_amdgcn_mfma_f32_16x16x32_bf16(xf[db][ks], yf[ks], acc, 0, 0, 0);
                const int d = db * 16 + 4 * fq;
                u32x2 w; w.x = cvt_pk_bf16(acc[0] * s4[db][0], acc[1] * s4[db][1]); w.y = cvt_pk_bf16(acc[2] * s4[db][2], acc[3] * s4[db][3]);
                *(u32x2*)(yb + (size_t)(tok0 + t0 + fr) * D + CONV_W + g * 64 + d) = w;
            }
        }
    }
    __syncthreads();
}
constexpr int VN_LD = 200;
__device__ __forceinline__ void tr_read2(unsigned a0, unsigned a1, u16x4& lo, u16x4& hi) {
    asm volatile("ds_read_b64_tr_b16 %0, %2\n\tds_read_b64_tr_b16 %1, %3\n\ts_waitcnt lgkmcnt(0)" : "=&v"(lo), "=&v"(hi) : "v"(a0), "v"(a1) : "memory"); }
__device__ __forceinline__ void mixer_sgu(const Frame& F, unsigned char* ws, int l, int tok0, int h0) {
    const int tid = tid_l(), lane = tid & 63, wave = __builtin_amdgcn_readfirstlane(tid >> 6);
    const bf16_t* zb = WSP(const bf16_t, ws, WS_Z); bf16_t* yb = WSP(bf16_t, ws, WS_Y); const float* sm = WSP(const float, ws, WS_SMALL);
    LAS bf16_t* VN = (LAS bf16_t*)F.lds;
    {
        const int tk = lane >> 4, li = lane & 15;
        const float* gp = sm + SM_LNG + (size_t)l * SGU_W; const float* bp = sm + SM_LNB + (size_t)l * SGU_W;
        u32x4 raw[4][3];
#pragma unroll
        for (int it = 0; it < 4; ++it)
#pragma unroll
            for (int j = 0; j < 3; ++j) raw[it][j] = *(const u32x4*)(zb + (size_t)(tok0 + wave * 16 + it * 4 + tk) * ZLD + OFF_V + (li + 16 * j) * 8);
        f32x4 gg[3][2], bb[3][2];
#pragma unroll
        for (int j = 0; j < 3; ++j) { const int cvv = li + 16 * j; const bool in = cvv >= 8 * h0 && cvv < 8 * h0 + 24; const int cc = in ? cvv * 8 : 0;
            gg[j][0] = *(const f32x4*)(gp + cc); gg[j][1] = *(const f32x4*)(gp + cc + 4); bb[j][0] = *(const f32x4*)(bp + cc); bb[j][1] = *(const f32x4*)(bp + cc + 4); }
#pragma unroll
        for (int it = 0; it < 4; ++it) {
            const int t = wave * 16 + it * 4 + tk;
            float v[3][8]; float s = 0.f;
#pragma unroll
            for (int j = 0; j < 3; ++j) { unpack8(raw[it][j], v[j]);
#pragma unroll
                for (int q = 0; q < 8; ++q) s += v[j][q]; }
            s += __shfl_xor(s, 1); s += __shfl_xor(s, 2); s += __shfl_xor(s, 4); s += __shfl_xor(s, 8);
            const float mu = s * (1.0f / SGU_W); float qq = 0.f;
#pragma unroll
            for (int j = 0; j < 3; ++j)
#pragma unroll
                for (int q = 0; q < 8; ++q) { const float d = v[j][q] - mu; qq += d * d; }
            qq += __shfl_xor(qq, 1); qq += __shfl_xor(qq, 2); qq += __shfl_xor(qq, 4); qq += __shfl_xor(qq, 8);
            const float rs = rsqrtf(qq * (1.0f / SGU_W) + LN_EPS);
#pragma unroll
            for (int j = 0; j < 3; ++j) { const int cvv = li + 16 * j;
                if (cvv >= 8 * h0 && cvv < 8 * h0 + 24) { float o[8];
#pragma unroll
                    for (int q = 0; q < 8; ++q) o[q] = (v[j][q] - mu) * rs * gg[j][q >> 2][q & 3] + bb[j][q >> 2][q & 3];
                    *(LAS u32x4*)(VN + t * VN_LD + (cvv - 8 * h0) * 8) = pack8(o); } }
        }
    }
    __syncthreads();
    {
        const int fr = lane & 15, fq = lane >> 4, t0 = wave * 16, nks = (wave >> 1) + 1;
        const unsigned vn_base = (unsigned)(size_t)VN;
        const int q = fr >> 2, pp = fr & 3;
        const bf16_t* sguw = WSP(const bf16_t, ws, WS_SGUW);
        bf16x8 yf[3][4]; float bias[3]; u32x2 uu[3][4];
#pragma unroll
        for (int hh = 0; hh < 3; ++hh) { const int h = h0 + hh;
            const bf16_t* wsp = sguw + ((size_t)(l * 6 + h) * 128 + t0 + fr) * 128 + fq * 8;
#pragma unroll
            for (int ks = 0; ks < 4; ++ks) yf[hh][ks] = *(const bf16x8*)(wsp + ks * 32);
            bias[hh] = sm[SM_SGUB + (l * 6 + h) * 128 + t0 + fr];
#pragma unroll
            for (int db = 0; db < 4; ++db) uu[hh][db] = *(const u32x2*)(zb + (size_t)(tok0 + t0 + fr) * ZLD + OFF_U + h * 64 + db * 16 + 4 * fq); }
#pragma unroll
        for (int hh = 0; hh < 3; ++hh) {
            const int h = h0 + hh;
#pragma unroll
            for (int db = 0; db < 4; ++db) {
                f32x4 acc = (f32x4){0.f, 0.f, 0.f, 0.f};
#pragma unroll
                for (int ks = 0; ks < 4; ++ks) if (ks < nks) {
                    const unsigned a0 = vn_base + (unsigned)((ks * 32 + 8 * fq + q) * VN_LD + hh * 64 + db * 16 + 4 * pp) * 2u;
                    u16x4 lo, hi; tr_read2(a0, a0 + 4u * VN_LD * 2u, lo, hi);
                    bf16x8 xf; xf[0] = (short)lo[0]; xf[1] = (short)lo[1]; xf[2] = (short)lo[2]; xf[3] = (short)lo[3]; xf[4] = (short)hi[0]; xf[5] = (short)hi[1]; xf[6] = (short)hi[2]; xf[7] = (short)hi[3];
                    acc = __builtin_amdgcn_mfma_f32_16x16x32_bf16(xf, yf[hh][ks], acc, 0, 0, 0);
                }
                const int d = db * 16 + 4 * fq; const u32x2 u2 = uu[hh][db]; const float bs = bias[hh];
                u32x2 w; w.x = cvt_pk_bf16(bf_lo(u2.x) * (acc[0] + bs), bf_hi(u2.x) * (acc[1] + bs)); w.y = cvt_pk_bf16(bf_lo(u2.y) * (acc[2] + bs), bf_hi(u2.y) * (acc[3] + bs));
                *(u32x2*)(yb + (size_t)(tok0 + t0 + fr) * D + CONV_W + POOL_W + h * 64 + d) = w;
            }
        }
    }
    __syncthreads();
}
__device__ __forceinline__ void phase_mixer(const Frame& F, int l) {
    unsigned char* ws = wsl(F);
    for (int u = F.wg; u < 512; u += F.G) {
        const int part = u >> 7, bn = u & 127, tok0 = bn * CHUNK, n = bn & 15;
        if (part == 0) { for (int r = 0; r < 1 + ((REP_MASK >> 11) & 1); ++r) mixer_conv(F, ws, l, tok0, n); }
        else if (part == 1) { for (int r = 0; r < 1 + ((REP_MASK >> 12) & 1); ++r) mixer_pool(F, ws, l, tok0, n); }
        else { for (int r = 0; r < 1 + ((REP_MASK >> 13) & 1); ++r) mixer_sgu(F, ws, l, tok0, part == 2 ? 0 : 3); }
    }
}

__device__ __forceinline__ void phase_ln1_router(const Frame& F, int l, bool dispatch) {
    const int tid = tid_l(), lane = tid & 63, wave = __builtin_amdgcn_readfirstlane(tid >> 6), wg = F.wg;
    unsigned char* ws = wsl(F);
    const bf16_t* xres = WSP(const bf16_t, ws, WS_X); bf16_t* xdst = WSP(bf16_t, ws, WS_X2); bf16_t* hb = WSP(bf16_t, ws, WS_H); const float* sm = WSP(const float, ws, WS_SMALL);
    LAS float* wrt = (LAS float*)F.lds;
    LAS int* hist = (LAS int*)(F.lds + MISC_OFF + 16);
    LAS int* base = hist + 32;
    LAS int* asg_e = base + 32; LAS int* asg_r = asg_e + 128; LAS float* asg_w = (LAS float*)(asg_r + 128);
    { const float* wrt_g = WSP(const float, ws, WS_WRT); f32x4 t4[16];
#pragma unroll
      for (int i = 0; i < 16; ++i) t4[i] = *(const f32x4*)(wrt_g + (size_t)(tid + i * NTHR) * 4);
#pragma unroll
      for (int i = 0; i < 16; ++i) { const int i4 = tid + i * NTHR, e = i4 >> 8, rem = i4 & 255, jj = (rem >> 7) * 2 + (rem & 1), ln = (rem & 127) >> 1;
          *(LAS f32x4*)(wrt + ((e * 4 + jj) * 64 + ln) * 4) = t4[i]; } }
    if (tid < 32) hist[tid] = 0;
    __syncthreads();
    const float* ada_l = WSP(const float, ws, WS_ADA) + (size_t)l * NB * 6144;
    const float* lgp = sm + SM_LN1G + (size_t)l * D + 8 * lane; const float* lbp = sm + SM_LN1B + (size_t)l * D + 8 * lane;
    for (int tg = wg; tg < T / 64; tg += F.G) {
        const int tokb = tg * 64, b = tokb / SEQ;
        const float* shp = ada_l + (size_t)b * 6144 + 3072 + 8 * lane; const float* scp = shp + 1024;
        for (int pass = 0; pass < 4; ++pass) {
            f32x4 hv[2][4];
            u32x4 raw[2][2];
#pragma unroll
            for (int tk = 0; tk < 2; ++tk)
#pragma unroll
                for (int j = 0; j < 2; ++j) raw[tk][j] = *(const u32x4*)(xres + (size_t)(tokb + wave * 8 + pass * 2 + tk) * D + 512 * j + 8 * lane);
#pragma unroll
            for (int tk = 0; tk < 2; ++tk) {
                const int tok = tokb + wave * 8 + pass * 2 + tk;
                float v[2][8]; float s = 0.f;
#pragma unroll
                for (int j = 0; j < 2; ++j) { unpack8(raw[tk][j], v[j]);
#pragma unroll
                    for (int q = 0; q < 8; ++q) s += v[j][q]; }
                s = wave_sum(s); const float mu = s * (1.0f / D); float qq = 0.f;
#pragma unroll
                for (int j = 0; j < 2; ++j)
#pragma unroll
                    for (int q = 0; q < 8; ++q) { const float d = v[j][q] - mu; qq += d * d; }
                qq = wave_sum(qq); const float rs = rsqrtf(qq * (1.0f / D) + LN_EPS);
#pragma unroll
                for (int j = 0; j < 2; ++j) { float xn[8], hh[8];
#pragma unroll
                    for (int h2 = 0; h2 < 2; ++h2) { const f32x4 g4 = *(const f32x4*)(lgp + 512 * j + 4 * h2), b4 = *(const f32x4*)(lbp + 512 * j + 4 * h2), sc4 = *(const f32x4*)(scp + 512 * j + 4 * h2), sh4 = *(const f32x4*)(shp + 512 * j + 4 * h2);
#pragma unroll
                        for (int q = 0; q < 4; ++q) { const float x = (v[j][h2 * 4 + q] - mu) * rs * g4[q] + b4[q]; xn[h2 * 4 + q] = x; const float hq = x * (sc4[q] + 1.0f) + sh4[q]; hh[h2 * 4 + q] = hq; hv[tk][j * 2 + h2][q] = hq; } }
                    *(u32x4*)(xdst + (size_t)tok * D + 512 * j + 8 * lane) = pack8(xn);
                    *(u32x4*)(hb + (size_t)tok * D + 512 * j + 8 * lane) = pack8(hh); }
            }
            float pa[64];
            {
                const unsigned wbase = (unsigned)(size_t)wrt + 16u * (unsigned)lane;
#pragma unroll
                for (int eb = 0; eb < 8; ++eb) {
                    f32x4 w4[16]; const unsigned ab = wbase + (unsigned)eb * 16384u;
                    asm volatile("ds_read_b128 %0, %16\n\tds_read_b128 %1, %16 offset:1024\n\tds_read_b128 %2, %16 offset:2048\n\tds_read_b128 %3, %16 offset:3072\n\t"
                                 "ds_read_b128 %4, %16 offset:4096\n\tds_read_b128 %5, %16 offset:5120\n\tds_read_b128 %6, %16 offset:6144\n\tds_read_b128 %7, %16 offset:7168\n\t"
                                 "ds_read_b128 %8, %16 offset:8192\n\tds_read_b128 %9, %16 offset:9216\n\tds_read_b128 %10, %16 offset:10240\n\tds_read_b128 %11, %16 offset:11264\n\t"
                                 "ds_read_b128 %12, %16 offset:12288\n\tds_read_b128 %13, %16 offset:13312\n\tds_read_b128 %14, %16 offset:14336\n\tds_read_b128 %15, %16 offset:15360\n\t"
                                 "s_waitcnt lgkmcnt(0)"
                                 : "=&v"(w4[0]), "=&v"(w4[1]), "=&v"(w4[2]), "=&v"(w4[3]), "=&v"(w4[4]), "=&v"(w4[5]), "=&v"(w4[6]), "=&v"(w4[7]),
                                   "=&v"(w4[8]), "=&v"(w4[9]), "=&v"(w4[10]), "=&v"(w4[11]), "=&v"(w4[12]), "=&v"(w4[13]), "=&v"(w4[14]), "=&v"(w4[15])
                                 : "v"(ab) : "memory");
#pragma unroll
                    for (int ee = 0; ee < 4; ++ee) { float a0 = 0.f, a1 = 0.f;
#pragma unroll
                        for (int j = 0; j < 4; ++j) { const f32x4 w = w4[ee * 4 + j];
                            a0 += hv[0][j][0] * w[0] + hv[0][j][1] * w[1] + hv[0][j][2] * w[2] + hv[0][j][3] * w[3];
                            a1 += hv[1][j][0] * w[0] + hv[1][j][1] * w[1] + hv[1][j][2] * w[2] + hv[1][j][3] * w[3]; }
                        pa[eb * 4 + ee] = a0; pa[32 + eb * 4 + ee] = a1; }
                }
            }
#pragma unroll
            for (int i = 0; i < 32; ++i) { const float snd = (lane & 32) ? pa[i] : pa[32 + i], kp = (lane & 32) ? pa[32 + i] : pa[i]; pa[i] = kp + __shfl_xor(snd, 32); }
#pragma unroll
            for (int i = 0; i < 16; ++i) { const float snd = (lane & 16) ? pa[i] : pa[16 + i], kp = (lane & 16) ? pa[16 + i] : pa[i]; pa[i] = kp + __shfl_xor(snd, 16); }
#pragma unroll
            for (int i = 0; i < 8; ++i) { const float snd = (lane & 8) ? pa[i] : pa[8 + i], kp = (lane & 8) ? pa[8 + i] : pa[i]; pa[i] = kp + __shfl_xor(snd, 8); }
#pragma unroll
            for (int i = 0; i < 4; ++i) { const float snd = (lane & 4) ? pa[i] : pa[4 + i], kp = (lane & 4) ? pa[4 + i] : pa[i]; pa[i] = kp + __shfl_xor(snd, 4); }
#pragma unroll
            for (int i = 0; i < 2; ++i) { const float snd = (lane & 2) ? pa[i] : pa[2 + i], kp = (lane & 2) ? pa[2 + i] : pa[i]; pa[i] = kp + __shfl_xor(snd, 2); }
            { const float snd = (lane & 1) ? pa[0] : pa[1], kp = (lane & 1) ? pa[1] : pa[0]; pa[0] = kp + __shfl_xor(snd, 1); }
            const int e_me = lane & 31;
            const float logit = pa[0] + sm[SM_BR + e_me];
            float mx = logit;
#pragma unroll
            for (int o = 16; o; o >>= 1) mx = fmaxf(mx, __shfl_xor(mx, o));
            const float ex = __expf(logit - mx); float smm = ex;
#pragma unroll
            for (int o = 16; o; o >>= 1) smm += __shfl_xor(smm, o);
            const float pr = ex / smm;
            int rank = 0;
#pragma unroll
            for (int k = 1; k < 8; ++k) { const float po = __shfl_xor(pr, k); const int jo = (e_me ^ k); rank += (po > pr || (po == pr && jo < e_me)) ? 1 : 0; }
            float gsc = rank < 2 ? pr : 0.f;
            gsc += __shfl_xor(gsc, 1); gsc += __shfl_xor(gsc, 2); gsc += __shfl_xor(gsc, 4);
            int gsel = 0; float best = -1.f;
#pragma unroll
            for (int g = 0; g < 4; ++g) { const float sg = __shfl(gsc, (lane & 32) + 8 * g); if (sg > best) { best = sg; gsel = g; } }
            const bool ing = (e_me >> 3) == gsel;
            const unsigned long long m0 = __ballot(ing && rank == 0), m1 = __ballot(ing && rank == 1);
            const unsigned h0m = (unsigned)(m0 >> (lane & 32)), h1m = (unsigned)(m1 >> (lane & 32));
            const int e0 = __ffs(h0m) - 1, e1 = __ffs(h1m) - 1;
            const float p0 = __shfl(pr, (lane & 32) + e0), p1 = __shfl(pr, (lane & 32) + e1);
            if (dispatch && (lane & 31) < 2) {
                const int k = lane & 1, tk = lane >> 5, e = k ? e1 : e0; const float w = (k ? p1 : p0) / (p0 + p1);
                const int al = (wave * 8 + pass * 2 + tk) * 2 + k;
                asg_e[al] = e; asg_w[al] = w; asg_r[al] = atomicAdd((int*)(hist + e), 1);
            }
        }
        __syncthreads();
        if (!dispatch) continue;
        unsigned* cnt = WSP(unsigned, ws, WS_CTL + CTL_CNT);
        if (tid < 32) { const int hc = hist[tid]; base[tid] = hc ? (int)__hip_atomic_fetch_add(cnt + (l * 32 + tid) * 64, (unsigned)hc, __ATOMIC_RELAXED, __HIP_MEMORY_SCOPE_AGENT) : 0; }
        __syncthreads();
        if (tid < 128) { const int e = asg_e[tid], pos = base[e] + asg_r[tid]; WSP(int, ws, WS_LISTA)[e * LCAP + pos] = (tokb + (tid >> 1)) * 2 + (tid & 1); WSP(float, ws, WS_LISTW)[e * LCAP + pos] = asg_w[tid]; }
        __syncthreads();
        if (tid < 32) hist[tid] = 0;
        __syncthreads();
    }
}

__device__ __forceinline__ void phase_ln2(const Frame& F, int l, float* out) {
    const int tid = tid_l(), lane = tid & 63, wave = __builtin_amdgcn_readfirstlane(tid >> 6), wg = F.wg;
    unsigned char* ws = wsl(F);
    const bool lastl = (l == DEPTH - 1);
    const float* sm = WSP(const float, ws, WS_SMALL);
    const float* ada_l = WSP(const float, ws, WS_ADA) + (size_t)l * NB * 6144; const float* ada_n = WSP(const float, ws, WS_ADA) + (size_t)(lastl ? l : l + 1) * NB * 6144;
    const bf16_t* xres = WSP(const bf16_t, ws, WS_X2); const bf16_t* ymoe = WSP(const bf16_t, ws, WS_YMOE); bf16_t* hb = WSP(bf16_t, ws, WS_H); bf16_t* xdst = WSP(bf16_t, ws, WS_X);
    const float* lgp = sm + SM_LN2G + (size_t)l * D + 8 * lane; const float* lbp = sm + SM_LN2B + (size_t)l * D + 8 * lane;
    for (int tg = wg; tg < T / 64; tg += F.G) {
        const int tokb = tg * 64, b = tokb / SEQ;
        const float* g2p = ada_l + (size_t)b * 6144 + 5120 + 8 * lane; const float* shp = ada_n + (size_t)b * 6144 + 8 * lane; const float* scp = shp + 1024;
        for (int pass = 0; pass < 4; ++pass) {
            u32x4 rx[2][2], ry0[2][2], ry1[2][2];
#pragma unroll
            for (int tk = 0; tk < 2; ++tk)
#pragma unroll
                for (int j = 0; j < 2; ++j) { const int tok = tokb + wave * 8 + pass * 2 + tk; const size_t co = 512 * j + 8 * lane;
                    rx[tk][j] = *(const u32x4*)(xres + (size_t)tok * D + co); ry0[tk][j] = *(const u32x4*)(ymoe + (size_t)(2 * tok) * D + co); ry1[tk][j] = *(const u32x4*)(ymoe + (size_t)(2 * tok + 1) * D + co); }
#pragma unroll
            for (int tk = 0; tk < 2; ++tk) {
                const int tok = tokb + wave * 8 + pass * 2 + tk;
                float v[2][8]; float s = 0.f;
#pragma unroll
                for (int j = 0; j < 2; ++j) { float xv[8], a0[8], a1[8]; unpack8(rx[tk][j], xv); unpack8(ry0[tk][j], a0); unpack8(ry1[tk][j], a1);
#pragma unroll
                    for (int h2 = 0; h2 < 2; ++h2) { const f32x4 g4 = *(const f32x4*)(g2p + 512 * j + 4 * h2);
#pragma unroll
                        for (int q = 0; q < 4; ++q) { const float t = xv[h2 * 4 + q] * ALPHA + g4[q] * (a0[h2 * 4 + q] + a1[h2 * 4 + q]); v[j][h2 * 4 + q] = t; s += t; } } }
                s = wave_sum(s); const float mu = s * (1.0f / D); float qq = 0.f;
#pragma unroll
                for (int j = 0; j < 2; ++j)
#pragma unroll
                    for (int q = 0; q < 8; ++q) { const float d = v[j][q] - mu; qq += d * d; }
                qq = wave_sum(qq); const float rs = rsqrtf(qq * (1.0f / D) + LN_EPS);
#pragma unroll
                for (int j = 0; j < 2; ++j) { float xn[8], hh[8];
#pragma unroll
                    for (int h2 = 0; h2 < 2; ++h2) { const f32x4 g4 = *(const f32x4*)(lgp + 512 * j + 4 * h2), b4 = *(const f32x4*)(lbp + 512 * j + 4 * h2), sc4 = *(const f32x4*)(scp + 512 * j + 4 * h2), sh4 = *(const f32x4*)(shp + 512 * j + 4 * h2);
#pragma unroll
                        for (int q = 0; q < 4; ++q) { const float x = (v[j][h2 * 4 + q] - mu) * rs * g4[q] + b4[q]; xn[h2 * 4 + q] = x; hh[h2 * 4 + q] = x * (sc4[q] + 1.0f) + sh4[q]; } }
                    if (lastl) { float* op = out + (size_t)tok * D + 512 * j + 8 * lane; *(f32x4*)op = (f32x4){xn[0], xn[1], xn[2], xn[3]}; *(f32x4*)(op + 4) = (f32x4){xn[4], xn[5], xn[6], xn[7]}; }
                    else { *(u32x4*)(xdst + (size_t)tok * D + 512 * j + 8 * lane) = pack8(xn); *(u32x4*)(hb + (size_t)tok * D + 512 * j + 8 * lane) = pack8(hh); } }
            }
        }
    }
}

__device__ __forceinline__ int moe_sched(const Frame& F, unsigned char* ws, int l) {
    LAS int* sc = (LAS int*)(F.lds + SCHED_OFF);
    const int tid = tid_l();
    if (tid < 32) sc[tid] = (int)__hip_atomic_load(WSP(unsigned, ws, WS_CTL + CTL_CNT) + (l * 32 + tid) * 64, __ATOMIC_RELAXED, __HIP_MEMORY_SCOPE_AGENT);
    __syncthreads();
    if (tid == 0) { int a = 0; for (int e = 0; e < 32; ++e) { sc[32 + e] = a; a += (sc[e] + 255) >> 8; } sc[64] = a; }
    __syncthreads();
    const int NT = sc[64];
    for (int tl = tid; tl < NT; tl += NTHR) { int e = 0; for (int k = 1; k < 32; ++k) e = (sc[32 + k] <= tl) ? k : e; sc[96 + tl] = e; }
    __syncthreads();
    return NT;
}

constexpr int N_PHASES = 2 + 7 * DEPTH;
#ifndef PH_MASK
#define PH_MASK 0x1ff
#endif
#ifndef NG_IN
#define NG_IN 3
#endif
#ifndef NG_M1
#define NG_M1 3
#endif
#ifndef NG_M2
#define NG_M2 1
#endif
#define REP(b) for (int _rep = 0; _rep < 1 + ((REP_MASK >> (b)) & 1); ++_rep, (void)((((REP_MASK >> 10) & 1) && _rep == 1) ? (GRID_BAR(), 0) : 0))
__global__ void __launch_bounds__(NTHR, 2) fwd_kernel(Params p) {
    extern __shared__ __attribute__((aligned(16))) unsigned char lds_raw[];
    Frame F;
    F.lds = (LAS unsigned char*)lds_raw;
    F.wg = blockIdx.x; F.G = gridDim.x;
    F.ws = p.ws;

    volatile LAS unsigned* xbw = (volatile LAS unsigned*)(F.lds + MISC_OFF);
    if (threadIdx.x < 4) xbw[threadIdx.x] = 0u;
    __syncthreads();
    XcdBarrier bar; bar.bar = (unsigned*)(p.ws + WS_CTL); bar.x = 0; bar.st = xbw;
#if ONE_LAUNCH
    bar = xcd_barrier_post((unsigned*)(p.ws + WS_CTL), xbw);
#define GRID_BAR() xcd_barrier(bar)
#else
#define GRID_BAR() do { } while (0)
#endif
    const int lo = p.ph_lo, hi = p.ph_hi;
#define IN(k) (lo <= (k) && (k) < hi)
#define EN(b) ((PH_MASK >> (b)) & 1)
#define SEAM(k) do { if (IN((k) + 1)) GRID_BAR(); } while (0)

    if (EN(0) && IN(0)) { REP(0) phase_prep(F, p); SEAM(0); }
    if (EN(1) && IN(1)) { REP(1) phase_h0(F, p.in[0]); SEAM(1); }
    for (int l = 0; l < DEPTH; ++l) {
        const int pb = 2 + 7 * l;
        if (EN(2) && IN(pb + 0)) {
            unsigned char* ws = wsl(F);
            PolIn P; P.K = D; P.A = WSP(const char, ws, WS_H); P.B = (const char*)(WSP(bf16_t, ws, WS_WIN) + (size_t)l * ZLD * D); P.lista = nullptr; P.listw = nullptr; P.ord.init(T, ZLD, F.G, F.wg); P.Z = WSP(bf16_t, ws, WS_Z);
            REP(2) gemm_phase<PolIn>(F.lds, P);
            if (F.wg >= 576 - 2 * 256) fill_prep(F, p, l == 0 ? 1 : l, NG_IN);
            SEAM(pb + 0);
        }
        if (EN(3) && IN(pb + 1)) { REP(3) phase_mixer(F, l); SEAM(pb + 1); if ((REP_MASK >> 9) & 1) { GRID_BAR(); GRID_BAR(); GRID_BAR(); GRID_BAR(); } }
        if (EN(4) && IN(pb + 2)) {
            unsigned char* ws = wsl(F);
            PolOut P; P.K = D; P.A = WSP(const char, ws, WS_Y); P.B = (const char*)(WSP(bf16_t, ws, WS_WOUT) + (size_t)l * D * D); P.lista = nullptr; P.listw = nullptr; P.ord.init(T, D, F.G, F.wg);
            P.xres = WSP(bf16_t, ws, WS_X); P.g1 = WSP(const float, ws, WS_ADA) + (size_t)l * NB * 6144 + 2048;
            for (int _r = 0; _r < 1 + (((REP_MASK >> 4) & 1) && l == 0); ++_r) gemm_phase<PolOut>(F.lds, P);
            SEAM(pb + 2);
        }
        if (EN(5) && IN(pb + 3)) { phase_ln1_router(F, l, true); if ((REP_MASK >> 5) & 1) phase_ln1_router(F, l, false); fill_prep(F, p, l, -1); SEAM(pb + 3); }
        if (EN(6) && IN(pb + 4)) {
            unsigned char* ws = wsl(F);
            const int NT = moe_sched(F, ws, l);
            PolMoe1 P; P.K = D; P.A = WSP(const char, ws, WS_H); P.B = (const char*)(WSP(bf16_t, ws, WS_WGU) + (size_t)l * NE * 1024 * 1024); P.lista = WSP(const int, ws, WS_LISTA); P.listw = WSP(const float, ws, WS_LISTW);
            P.ord.sched = (const LAS int*)(F.lds + SCHED_OFF); P.ord.NT = NT; P.ord.G = F.G; P.ord.c = F.wg; P.act = WSP(bf16_t, ws, WS_ACT);
            REP(6) gemm_phase<PolMoe1>(F.lds, P);
            { const int U = NT * 4, mx = (U + F.G - 1) / F.G, mine = F.wg < U ? (U - F.wg + F.G - 1) / F.G : 0; fill_prep(F, p, l + 1, (mx - mine) * NG_M1); }
            SEAM(pb + 4);
        }
        if (EN(7) && IN(pb + 5)) {
            unsigned char* ws = wsl(F);
            const int NT = moe_sched(F, ws, l);
            PolMoe2 P; P.K = DFF; P.A = WSP(const char, ws, WS_ACT); P.B = (const char*)(WSP(bf16_t, ws, WS_WDN) + (size_t)l * NE * 1024 * DFF); P.lista = WSP(const int, ws, WS_LISTA); P.listw = WSP(const float, ws, WS_LISTW);
            P.ord.sched = (const LAS int*)(F.lds + SCHED_OFF); P.ord.NT = NT; P.ord.G = F.G; P.ord.c = F.wg; P.ymoe = WSP(bf16_t, ws, WS_YMOE);
            REP(7) gemm_phase<PolMoe2>(F.lds, P);
            { const int U = NT * 4, mx = (U + F.G - 1) / F.G, mine = F.wg < U ? (U - F.wg + F.G - 1) / F.G : 0; fill_prep(F, p, l + 1, (mx - mine) * NG_M2); }
            SEAM(pb + 5);
        }
        if (EN(8) && IN(pb + 6)) { for (int _r = 0; _r < 1 + (((REP_MASK >> 8) & 1) && l == DEPTH - 1); ++_r) phase_ln2(F, l, p.out); if (l + 1 < DEPTH) SEAM(pb + 6); }
    }
#undef IN
#undef EN
#undef SEAM
}

extern "C" void kernel_launch(void* const* d_in, const int* in_sizes, int n_in, void* d_out, int out_size, void* d_ws, size_t ws_size, hipStream_t stream) {
    static int grid = 0;
    if (grid == 0) {
        if (n_in != 23 || out_size != T * D || ws_size < WS_END) { fprintf(stderr, "kernel_launch: unexpected shapes (n_in %d, out %d, ws %zu < %zu)\n", n_in, out_size, ws_size, (size_t)WS_END); grid = -1; return; }
        int dev = 0, cus = 0, per_cu = 0;
        if (hipGetDevice(&dev) != hipSuccess || hipDeviceGetAttribute(&cus, hipDeviceAttributeMultiprocessorCount, dev) != hipSuccess) { grid = -1; return; }
        if (hipFuncSetAttribute((const void*)fwd_kernel, hipFuncAttributeMaxDynamicSharedMemorySize, LDS_BYTES) != hipSuccess) { fprintf(stderr, "kernel_launch: hipFuncSetAttribute failed\n"); grid = -1; return; }
        if (hipOccupancyMaxActiveBlocksPerMultiprocessor(&per_cu, (const void*)fwd_kernel, NTHR, LDS_BYTES) != hipSuccess || per_cu < 1) { fprintf(stderr, "kernel_launch: occupancy query says %d\n", per_cu); (void)hipGetLastError(); per_cu = 1; }
        grid = cus;
        if (grid > 256) grid = 256;
    }
    if (grid < 0) return;
    (void)hipMemsetAsync((char*)d_ws + WS_CTL, 0, CTL_BYTES, stream);
    Params p{};
    for (int i = 0; i < 23; ++i) p.in[i] = (const float*)d_in[i];
    p.out = (float*)d_out; p.ws = (unsigned char*)d_ws;
#if ONE_LAUNCH
    p.ph_lo = 0; p.ph_hi = N_PHASES;
    hipLaunchKernelGGL(fwd_kernel, dim3(grid), dim3(NTHR), LDS_BYTES, stream, p);
#else
    for (int k = 0; k < N_PHASES; ++k) { p.ph_lo = k; p.ph_hi = k + 1; hipLaunchKernelGGL(fwd_kernel, dim3(grid), dim3(NTHR), LDS_BYTES, stream, p); }
#endif
}
```
